# Optimizing an MI355X kernel written in HIP

```python
import math
import jax, jax.numpy as jnp
from jax import lax
import numpy as np

D_MODEL = 2048
BATCH = 4
SEQ = 4096
DEPTH = 1

CTX_LEN = 256
GRID_W = 64
Q_BLOCK = 128
ROPE_THETA = 10000.0
EPS = 1e-6
ADA_CHUNKS = 6

A_HEADS = 16
A_KV_HEADS = 4
A_HEAD_DIM = 128
B_HEADS = 8
B_HEAD_DIM = 64
B_V_DIM = 2 * B_HEAD_DIM

A_Q = A_HEADS * A_HEAD_DIM
A_KV = A_KV_HEADS * A_HEAD_DIM
B_QK = B_HEADS * 2 * B_HEAD_DIM
B_V = B_HEADS * B_V_DIM
KV_WIDTH = 2 * A_KV + B_QK + B_V
IN_WIDTH = KV_WIDTH + A_Q + B_QK + 2 * D_MODEL

D_FF = -(-8 * D_MODEL // (3 * 256)) * 256

kernel_name = "hybrid_gqa_diffattn_prefix_dit_block"


def rms_norm(x, g):
    xf = x.astype(jnp.float32)
    y = xf * lax.rsqrt(jnp.mean(xf * xf, axis=-1, keepdims=True) + EPS)
    return (y * g.astype(jnp.float32)).astype(x.dtype)


def modulate(h, shift, scale):
    return h * (1 + scale) + shift


def adaln(cond, w_ada, b_ada):
    return jnp.split(jax.nn.silu(cond) @ w_ada + b_ada, ADA_CHUNKS, axis=-1)


def axial_rope(rows, head_dim):
    n_freq = head_dim // 4
    freqs = ROPE_THETA ** (-jnp.arange(n_freq, dtype=jnp.float32) / n_freq)
    row = jnp.repeat(jnp.arange(rows, dtype=jnp.float32), GRID_W)
    col = jnp.tile(jnp.arange(GRID_W, dtype=jnp.float32), rows)
    ang = jnp.concatenate([row[:, None] * freqs, col[:, None] * freqs], axis=-1)
    return jnp.cos(ang), jnp.sin(ang)


def apply_rope(x, cos, sin):
    half = x.shape[-1] // 2
    shape = (cos.shape[0],) + (1,) * (x.ndim - 3) + (half,)
    cos = cos.reshape(shape).astype(x.dtype)
    sin = sin.reshape(shape).astype(x.dtype)
    x1, x2 = x[..., :half], x[..., half:]
    return jnp.concatenate([x1 * cos - x2 * sin, x2 * cos + x1 * sin], axis=-1)


def split_kv(p_kv, k_norm_a, k_norm_b):
    b, n = p_kv.shape[:2]
    k_a, v_a, k_b, v_b = jnp.split(p_kv, [A_KV, 2 * A_KV, 2 * A_KV + B_QK], axis=-1)
    k_a = rms_norm(k_a.reshape(b, n, A_KV_HEADS, A_HEAD_DIM), k_norm_a)
    v_a = v_a.reshape(b, n, A_KV_HEADS, A_HEAD_DIM)
    k_b = rms_norm(k_b.reshape(b, n, B_HEADS, 2, B_HEAD_DIM), k_norm_b)
    v_b = v_b.reshape(b, n, B_HEADS, B_V_DIM)
    return k_a, v_a, k_b, v_b


def split_qg(p_qg, q_norm_a, q_norm_b):
    b, n = p_qg.shape[:2]
    q_a, q_b, g_a, g_b = jnp.split(p_qg, [A_Q, A_Q + B_QK, A_Q + B_QK + D_MODEL], axis=-1)
    q_a = rms_norm(q_a.reshape(b, n, A_HEADS, A_HEAD_DIM), q_norm_a)
    q_b = rms_norm(q_b.reshape(b, n, B_HEADS, 2, B_HEAD_DIM), q_norm_b)
    return q_a, q_b, g_a, g_b


def gqa(q, k, v):
    b, n, hq, d = q.shape
    hkv = k.shape[2]
    qg = q.reshape(b, n, hkv, hq // hkv, d)
    s = jnp.einsum('bnkgd,bmkd->bkgnm', qg, k).astype(jnp.float32) * (d ** -0.5)
    p = jax.nn.softmax(s, axis=-1).astype(v.dtype)
    o = jnp.einsum('bkgnm,bmkd->bnkgd', p, v)
    return o.reshape(b, n, hq * d)


def diff_attn(q, k, v, lam, lam_init, subln_g):
    b, n, h, _, dh = q.shape
    s = jnp.einsum('bnhid,bmhid->bhinm', q, k).astype(jnp.float32) * (dh ** -0.5)
    p = jax.nn.softmax(s, axis=-1)
    a = (p[:, :, 0] - lam * p[:, :, 1]).astype(v.dtype)
    o = jnp.einsum('bhnm,bmhe->bnhe', a, v)
    o = rms_norm(o, subln_g) * (1 - lam_init)
    return o.reshape(b, n, h * B_V_DIM)


def sweep_query_blocks(attn_fn, q):
    b, s = q.shape[:2]
    nblk = s // Q_BLOCK
    qb = jnp.moveaxis(q.reshape((b, nblk, Q_BLOCK) + q.shape[2:]), 1, 0)
    o = lax.map(attn_fn, qb)
    return jnp.moveaxis(o, 0, 1).reshape(b, s, o.shape[-1])


def merge_branches(o_a, o_b, g_a, g_b, w_br_a, w_br_b, w_out):
    merged = jax.nn.sigmoid(g_a) * (o_a @ w_br_a) + jax.nn.sigmoid(g_b) * (o_b @ w_br_b)
    return merged @ w_out


def swiglu_sublayer(x, shift, scale, gate, norm_g, w_ff_gate, w_ff_up, w_ff_down):
    h = modulate(rms_norm(x, norm_g), shift, scale)
    return x + gate * ((jax.nn.silu(h @ w_ff_gate) * (h @ w_ff_up)) @ w_ff_down)


def setup_inputs(seed: int = 0) -> dict:
    key = jax.random.key(seed)
    ks = jax.random.split(key, 24)
    f32 = jnp.float32
    L = DEPTH

    def w(k, shape, fan_in, s=1.0):
        return jax.random.normal(k, shape, f32) * (s * fan_in ** -0.5)

    def gain(k, shape):
        return 1.0 + 0.05 * jax.random.normal(k, shape, f32)

    return {
        'x': jax.random.normal(ks[0], (BATCH, SEQ, D_MODEL), f32),
        'c': jax.random.normal(ks[1], (BATCH, D_MODEL), f32),
        'ctx': jax.random.normal(ks[2], (BATCH, CTX_LEN, D_MODEL), f32),
        'c_ctx': jax.random.normal(ks[3], (D_MODEL,), f32),
        'w_ada': w(ks[4], (L, D_MODEL, ADA_CHUNKS * D_MODEL), D_MODEL, 0.5),
        'b_ada': 0.02 * jax.random.normal(ks[5], (L, ADA_CHUNKS * D_MODEL), f32),
        'norm1_g': gain(ks[6], (L, D_MODEL)),
        'w_in': w(ks[7], (L, D_MODEL, IN_WIDTH), D_MODEL),
        'q_norm_a': gain(ks[8], (L, A_HEAD_DIM)),
        'k_norm_a': gain(ks[9], (L, A_HEAD_DIM)),
        'q_norm_b': gain(ks[10], (L, B_HEAD_DIM)),
        'k_norm_b': gain(ks[11], (L, B_HEAD_DIM)),
        'lam_q1': 0.1 * jax.random.normal(ks[12], (L, B_HEAD_DIM), f32),
        'lam_k1': 0.1 * jax.random.normal(ks[13], (L, B_HEAD_DIM), f32),
        'lam_q2': 0.1 * jax.random.normal(ks[14], (L, B_HEAD_DIM), f32),
        'lam_k2': 0.1 * jax.random.normal(ks[15], (L, B_HEAD_DIM), f32),
        'subln_g': gain(ks[16], (L, B_V_DIM)),
        'w_br_a': w(ks[17], (L, A_Q, D_MODEL), A_Q),
        'w_br_b': w(ks[18], (L, B_V, D_MODEL), B_V),
        'w_out': w(ks[19], (L, D_MODEL, D_MODEL), D_MODEL),
        'norm2_g': gain(ks[20], (L, D_MODEL)),
        'w_ff_gate': w(ks[21], (L, D_MODEL, D_FF), D_MODEL),
        'w_ff_up': w(ks[22], (L, D_MODEL, D_FF), D_MODEL),
        'w_ff_down': w(ks[23], (L, D_FF, D_MODEL), D_FF),
    }


def reference(x, c, ctx, c_ctx, w_ada, b_ada, norm1_g, w_in, q_norm_a, k_norm_a, q_norm_b, k_norm_b,
              lam_q1, lam_k1, lam_q2, lam_k2, subln_g, w_br_a, w_br_b, w_out, norm2_g,
              w_ff_gate, w_ff_up, w_ff_down):
    rows = x.shape[1] // GRID_W
    cos_a, sin_a = axial_rope(rows, A_HEAD_DIM)
    cos_b, sin_b = axial_rope(rows, B_HEAD_DIM)

    for l in range(DEPTH):
        last = l == DEPTH - 1
        lam_init = 0.8 - 0.6 * math.exp(-0.3 * l)
        lam = (jnp.exp(jnp.sum(lam_q1[l].astype(jnp.float32) * lam_k1[l].astype(jnp.float32)))
               - jnp.exp(jnp.sum(lam_q2[l].astype(jnp.float32) * lam_k2[l].astype(jnp.float32)))
               + lam_init)
        m_lat = [m[:, None, :] for m in adaln(c, w_ada[l], b_ada[l])]
        m_ctx = adaln(c_ctx, w_ada[l], b_ada[l])
        w_in_l = w_in[l]

        hc = modulate(rms_norm(ctx, norm1_g[l]), m_ctx[0], m_ctx[1])
        pc = hc @ (w_in_l[:, :KV_WIDTH] if last else w_in_l)
        ka_c, va_c, kb_c, vb_c = split_kv(pc[..., :KV_WIDTH], k_norm_a[l], k_norm_b[l])

        h = modulate(rms_norm(x, norm1_g[l]), m_lat[0], m_lat[1])
        p = h @ w_in_l
        ka, va, kb, vb = split_kv(p[..., :KV_WIDTH], k_norm_a[l], k_norm_b[l])
        qa, qb, ga, gb = split_qg(p[..., KV_WIDTH:], q_norm_a[l], q_norm_b[l])
        qa = apply_rope(qa, cos_a, sin_a)
        ka = apply_rope(ka, cos_a, sin_a)
        qb = apply_rope(qb, cos_b, sin_b)
        kb = apply_rope(kb, cos_b, sin_b)

        ka_all = jnp.concatenate([ka_c, ka], axis=1)
        va_all = jnp.concatenate([va_c, va], axis=1)
        kb_all = jnp.concatenate([kb_c, kb], axis=1)
        vb_all = jnp.concatenate([vb_c, vb], axis=1)
        sg = subln_g[l]
        oa = sweep_query_blocks(lambda qblk: gqa(qblk, ka_all, va_all), qa)
        ob = sweep_query_blocks(lambda qblk: diff_attn(qblk, kb_all, vb_all, lam, lam_init, sg), qb)
        x_new = x + m_lat[2] * merge_branches(oa, ob, ga, gb, w_br_a[l], w_br_b[l], w_out[l])
        x_new = swiglu_sublayer(x_new, m_lat[3], m_lat[4], m_lat[5], norm2_g[l],
                                w_ff_gate[l], w_ff_up[l], w_ff_down[l])

        if not last:
            qa_c, qb_c, ga_c, gb_c = split_qg(pc[..., KV_WIDTH:], q_norm_a[l], q_norm_b[l])
            oa_c = gqa(qa_c, ka_c, va_c)
            ob_c = diff_attn(qb_c, kb_c, vb_c, lam, lam_init, sg)
            ctx = ctx + m_ctx[2] * merge_branches(oa_c, ob_c, ga_c, gb_c, w_br_a[l], w_br_b[l], w_out[l])
            ctx = swiglu_sublayer(ctx, m_ctx[3], m_ctx[4], m_ctx[5], norm2_g[l],
                                  w_ff_gate[l], w_ff_up[l], w_ff_down[l])
        x = x_new
    return x
```

```cpp
#include <hip/hip_runtime.h>
#include <hip/hip_bf16.h>
#include <hip/hip_cooperative_groups.h>
#include <cstdio>
#include <cstdint>
namespace cg = cooperative_groups;

#ifndef MK_SINGLE
#define MK_SINGLE 1
#endif

#ifndef REPMASK
#define REPMASK 0
#endif
#define NREP(k) (1 + ((REPMASK >> (k)) & 1))
#define LAS __attribute__((address_space(3)))
typedef unsigned short bf16_t;
typedef short bf16x8 __attribute__((ext_vector_type(8)));
typedef short s16x4 __attribute__((ext_vector_type(4)));
typedef float f32x4 __attribute__((ext_vector_type(4)));
typedef float f32x16 __attribute__((ext_vector_type(16)));
typedef unsigned u32x4 __attribute__((ext_vector_type(4)));
typedef unsigned u32x2 __attribute__((ext_vector_type(2)));

constexpr int DM = 2048, NBATCH = 4, SEQ = 4096, CTXL = 256, SKV = SEQ + CTXL;
constexpr int MLAT = NBATCH * SEQ, MCTX = NBATCH * CTXL, MALL = MLAT + MCTX;
constexpr int KVW = 3072, INW = 10240, QGW = 7168, DFF = 5632, ADAW = 12288;
constexpr float EPS = 1e-6f;
constexpr float QSC_A = 0.088388347648318440f * 1.4426950408889634f, QSC_B = 0.125f * 1.4426950408889634f;
constexpr int NTHREADS = 512, NWAVES = 8;
constexpr int LDS_BYTES = 143360;

constexpr size_t MiB = 1u << 20;
constexpr size_t WS_MODP = 0;
constexpr size_t WS_MOD = 2 * MiB;
constexpr size_t WS_BAR = 3 * MiB;
constexpr size_t WS_WIN = 4 * MiB;
constexpr size_t WS_WD = 4 * MiB;
constexpr size_t WS_WBRA = 44 * MiB;
constexpr size_t WS_WBRB = 52 * MiB;
constexpr size_t WS_WOUT = 56 * MiB;
constexpr size_t WS_WGU = 64 * MiB;
constexpr size_t WS_H = 108 * MiB;
constexpr size_t WS_KV = 176 * MiB;
constexpr size_t WS_QG = 278 * MiB;
constexpr size_t WS_END = 502 * MiB;

__device__ __forceinline__ unsigned cvt_pk_bf16(float lo, float hi) { unsigned r; asm volatile("v_cvt_pk_bf16_f32 %0, %1, %2" : "=v"(r) : "v"(lo), "v"(hi)); return r; }
__device__ __forceinline__ float bf_lo(unsigned w) { return __uint_as_float(w << 16); }
__device__ __forceinline__ float bf_hi(unsigned w) { return __uint_as_float(w & 0xffff0000u); }
__device__ __forceinline__ float wave_sum(float v) {
#pragma unroll
    for (int o = 1; o < 64; o <<= 1) v += __shfl_xor(v, o);
    return v;
}
__device__ __forceinline__ float sigmoidf_(float x) { return __builtin_amdgcn_rcpf(1.0f + __builtin_amdgcn_exp2f(-1.4426950408889634f * x)); }
__device__ __forceinline__ void unpack8(u32x4 w, float* x) {
    x[0] = bf_lo(w.x); x[1] = bf_hi(w.x); x[2] = bf_lo(w.y); x[3] = bf_hi(w.y); x[4] = bf_lo(w.z); x[5] = bf_hi(w.z); x[6] = bf_lo(w.w); x[7] = bf_hi(w.w);
}
__device__ __forceinline__ u32x4 pack8(const float* x) {
    u32x4 w; w.x = cvt_pk_bf16(x[0], x[1]); w.y = cvt_pk_bf16(x[2], x[3]); w.z = cvt_pk_bf16(x[4], x[5]); w.w = cvt_pk_bf16(x[6], x[7]); return w;
}

namespace pg8 {
constexpr int BM = 256, BK = 64, HALF = 128, HTB = HALF * BK * 2, STAGE_BYTES = 8 * HTB, NXCD = 8, WGM = 8;
__host__ __device__ __forceinline__ int lds_byte(int r, int c) { const int st = (r >> 4) * 2 + (c >> 5), rr = r & 15, cc = c & 31, ob = rr * 64 + cc * 2; return st * 1024 + (ob ^ (((ob >> 9) & 1) << 5)); }
__host__ __device__ __forceinline__ void stage_rc(int b, int& R, int& C) { const int st = b / 1024, sb = b % 1024, swz = sb ^ (((sb >> 9) & 1) << 5); R = (st >> 1) * 16 + swz / 64; C = (st & 1) * 32 + (swz % 64) / 2; }
__host__ __device__ __forceinline__ int perm32(int rho) { const int n = rho >> 4, i = rho & 15; return 8 * (i >> 2) + 4 * n + (i & 3); }

struct Unit { int pm, pn; };
struct Gemm { const bf16_t* A; const bf16_t* Bt; int K, lda, ldb; };

struct StaticOrder {
    int nM, nN, nwg, G, c;
    __device__ void init(int M, int N, int G_, int c_) { nM = M / BM; nN = N / BM; nwg = nM * nN; G = G_; c = c_; }
    __device__ bool map(long L, Unit& u) const {
        if (L >= nwg) return false;
        int wgid = (int)L; { const int q = nwg / NXCD, r = nwg % NXCD, xcd = wgid % NXCD, off = wgid / NXCD; wgid = (xcd < r ? xcd * (q + 1) : r * (q + 1) + (xcd - r) * q) + off; }
        const int nig = WGM * nN, gid = wgid / nig, fm = gid * WGM, gsz = (nM - fm) < WGM ? (nM - fm) : WGM;
        u.pm = fm + ((wgid % nig) % gsz); u.pn = (wgid % nig) / gsz; return true;
    }
    __device__ bool next(int i, Unit& u) const { return map((long)i * G + c, u); }
};
struct InprojOrder {
    StaticOrder so;
    __device__ void init(int G_, int c_) { so.init(MLAT, INW, G_, c_); }
    __device__ bool next(int i, Unit& u) const {
        const long L = (long)i * so.G + so.c;
        if (L < so.nwg) return so.map(L, u);
        const int L2 = (int)(L - so.nwg); if (L2 >= 48) return false;
        u.pm = 64 + L2 / 12; u.pn = L2 % 12; return true;
    }
};

template <class Epi, class Sched, bool ALIGN_EPI = true>
__device__ __forceinline__ void gemm_phase(LAS unsigned char* lds, const Gemm g, const Sched& S, const Epi& E) {
    const int tid = threadIdx.x, wid = __builtin_amdgcn_readfirstlane(tid >> 6), lane = tid & 63, wr = wid >> 2, wc = wid & 3, fr = lane & 15, fq = lane >> 4;
    const int nt = g.K / BK;
    unsigned voffA[2], voffB[2];
#pragma unroll
    for (int i = 0; i < 2; ++i) { int R, C; stage_rc(tid * 16 + i * 8192, R, C); const int Rb = (R & ~31) + perm32(R & 31);
        voffA[i] = (unsigned)(R * g.lda + C) * 2u; voffB[i] = (unsigned)(Rb * g.ldb + C) * 2u; }
    const size_t kstep = (size_t)(BK * 2);
    const size_t hA = (size_t)HALF * g.lda * 2, hB = (size_t)HALF * g.ldb * 2, tA = 2 * hA, tB = 2 * hB;
    const unsigned ldsw = (unsigned)wid * 1024u;
    const int aoff = lds_byte(wr * 64 + fr, fq * 8), boff = lds_byte(wc * 32 + fr, fq * 8);
#define PG8_SA(b, h) (((b) * 2 + (h)) * HTB)
#define PG8_SB(b, h) ((4 + (b) * 2 + (h)) * HTB)
#define PG8_STAGE(bufoff, gbase, voff) do { _Pragma("unroll") for (int _i = 0; _i < 2; ++_i) \
        __builtin_amdgcn_global_load_lds((const unsigned*)((const char*)(gbase) + (voff)[_i]), (LAS unsigned*)(lds + (bufoff) + ldsw + _i * 8192), 16, 0, 0); } while (0)
#define PG8_LDA(dst, b, h) do { _Pragma("unroll") for (int m = 0; m < 4; ++m) _Pragma("unroll") for (int k = 0; k < 2; ++k) dst[m][k] = *(const LAS bf16x8*)(lds + PG8_SA(b, h) + aoff + m * 2048 + k * 1024); } while (0)
#define PG8_LDB(dst, b, h) do { _Pragma("unroll") for (int n = 0; n < 2; ++n) _Pragma("unroll") for (int k = 0; k < 2; ++k) dst[n][k] = *(const LAS bf16x8*)(lds + PG8_SB(b, h) + boff + n * 2048 + k * 1024); } while (0)
#define PG8_MMA(ai, bj, At, Bt) do { __builtin_amdgcn_s_setprio(1); _Pragma("unroll") for (int m = 0; m < 4; ++m) _Pragma("unroll") for (int n = 0; n < 2; ++n) _Pragma("unroll") for (int k = 0; k < 2; ++k) \
        acc[ai][bj][m][n] = __builtin_amdgcn_mfma_f32_16x16x32_bf16(Bt[n][k], At[m][k], acc[ai][bj][m][n], 0, 0, 0); __builtin_amdgcn_s_setprio(0); } while (0)
#define PG8_WAIT_V(n) asm volatile("s_waitcnt vmcnt(" #n ")" ::: "memory")
#define PG8_WAIT_L(n) asm volatile("s_waitcnt lgkmcnt(" #n ")" ::: "memory")
#define PG8_BAR __builtin_amdgcn_s_barrier()
#define PG8_SCHED __builtin_amdgcn_sched_barrier(0)
    Unit cur, nxt; int ui = 0;
    if (!S.next(0, cur)) return;
    f32x4 acc[2][2][4][2];
#pragma unroll
    for (int a = 0; a < 2; ++a)
#pragma unroll
        for (int b = 0; b < 2; ++b)
#pragma unroll
            for (int m = 0; m < 4; ++m)
#pragma unroll
                for (int n = 0; n < 2; ++n) acc[a][b][m][n] = (f32x4){0.f, 0.f, 0.f, 0.f};
    bf16x8 At[4][2], B0[2][2], B1[2][2];
    const char* cA = (const char*)g.A + (size_t)cur.pm * tA; const char* cB = (const char*)g.Bt + (size_t)cur.pn * tB;
    PG8_STAGE(PG8_SB(0, 0), cB, voffB); PG8_STAGE(PG8_SB(0, 1), cB + hB, voffB); PG8_STAGE(PG8_SA(0, 0), cA, voffA); PG8_STAGE(PG8_SA(0, 1), cA + hA, voffA);
    if (wr == 1) PG8_BAR;
    PG8_WAIT_V(2); PG8_BAR;
    PG8_STAGE(PG8_SB(1, 0), cB + kstep, voffB); PG8_STAGE(PG8_SA(1, 0), cA + kstep, voffA); PG8_STAGE(PG8_SB(1, 1), cB + hB + kstep, voffB);
    PG8_WAIT_V(6); PG8_BAR;
    for (;;) {
        const bool has_next = S.next(ui + 1, nxt);
        const char* nA = has_next ? (const char*)g.A + (size_t)nxt.pm * tA : cA; const char* nB = has_next ? (const char*)g.Bt + (size_t)nxt.pn * tB : cB;
        for (int t = 0; t < nt; t += 2) {
            const bool last = (t == nt - 2);
            const char* a1 = cA + (size_t)(t + 1) * kstep;
            const char* a2 = last ? nA : cA + (size_t)(t + 2) * kstep; const char* b2 = last ? nB : cB + (size_t)(t + 2) * kstep;
            const char* a3 = a2 + kstep; const char* b3 = b2 + kstep;
            PG8_LDB(B0, 0, 0); PG8_LDB(B1, 0, 1); PG8_SCHED; PG8_LDA(At, 0, 0); PG8_STAGE(PG8_SA(1, 1), a1 + hA, voffA);
            PG8_WAIT_V(8); PG8_WAIT_L(0); PG8_BAR; PG8_MMA(0, 0, At, B0); PG8_MMA(0, 1, At, B1); PG8_BAR; PG8_SCHED;
            PG8_LDA(At, 0, 1); PG8_STAGE(PG8_SB(0, 0), b2, voffB); PG8_STAGE(PG8_SB(0, 1), b2 + hB, voffB); PG8_STAGE(PG8_SA(0, 0), a2, voffA);
            PG8_WAIT_V(8); PG8_WAIT_L(0); PG8_BAR; PG8_MMA(1, 0, At, B0); PG8_MMA(1, 1, At, B1); PG8_BAR; PG8_SCHED;
            PG8_LDB(B0, 1, 0); PG8_LDB(B1, 1, 1); PG8_SCHED; PG8_LDA(At, 1, 0); PG8_STAGE(PG8_SA(0, 1), a2 + hA, voffA);
            PG8_WAIT_V(8); PG8_WAIT_L(0); PG8_BAR; PG8_MMA(0, 0, At, B0); PG8_MMA(0, 1, At, B1); PG8_BAR; PG8_SCHED;
            PG8_LDA(At, 1, 1); PG8_STAGE(PG8_SB(1, 0), b3, voffB); PG8_STAGE(PG8_SB(1, 1), b3 + hB, voffB); PG8_STAGE(PG8_SA(1, 0), a3, voffA);
            PG8_WAIT_V(8); PG8_WAIT_L(0); PG8_BAR; PG8_MMA(1, 0, At, B0); PG8_MMA(1, 1, At, B1); PG8_BAR; PG8_SCHED;
        }
        if constexpr (ALIGN_EPI) { if (wr == 0) PG8_BAR; }
        E(acc, cur, wr, wc, fr, fq);
        if (!has_next) break;
#pragma unroll
        for (int a = 0; a < 2; ++a)
#pragma unroll
            for (int b = 0; b < 2; ++b)
#pragma unroll
                for (int m = 0; m < 4; ++m)
#pragma unroll
                    for (int n = 0; n < 2; ++n) acc[a][b][m][n] = (f32x4){0.f, 0.f, 0.f, 0.f};
        cur = nxt; cA = nA; cB = nB; ++ui;
        if constexpr (ALIGN_EPI) { if (wr == 1) PG8_BAR; }
    }
    PG8_WAIT_V(0);
    if constexpr (!ALIGN_EPI) { if (wr == 0) PG8_BAR; }
    PG8_BAR;
#undef PG8_SA
#undef PG8_SB
#undef PG8_STAGE
#undef PG8_LDA
#undef PG8_LDB
#undef PG8_MMA
#undef PG8_WAIT_V
#undef PG8_WAIT_L
#undef PG8_BAR
#undef PG8_SCHED
}

typedef f32x4 Acc[2][2][4][2];
#define EPI_FENCE() asm volatile("" ::: "memory")

struct EpiInproj {
    bf16_t* KV; bf16_t* QG; const float* gka; const float* gkb; const float* gqa; const float* gqb; LAS float* X;
    __device__ __forceinline__ void operator()(const Acc& acc, const Unit& u, int wr, int wc, int fr_, int fq_) const {
        int fr = fr_, fq = fq_; asm volatile("" : "+v"(fr), "+v"(fq));
        bf16_t* base; size_t ld; int rowbase, colt; bool sig = false; int hk = 0; const float* g = nullptr; float osc = 1.f;
        if (u.pn < 12) { base = KV; ld = KVW; colt = u.pn * BM;
            if (u.pm < 64) rowbase = (u.pm >> 4) * SKV + CTXL + (u.pm & 15) * BM; else rowbase = (u.pm - 64) * SKV;
            if (u.pn < 2) { hk = 1; g = gka; } else if (u.pn >= 4 && u.pn < 8) { hk = 2; g = gkb; } }
        else { base = QG; ld = QGW; colt = (u.pn - 12) * BM; rowbase = u.pm * BM; sig = u.pn >= 24;
            if (u.pn < 20) { hk = 1; g = gqa; osc = QSC_A; } else if (u.pn < 24) { hk = 2; g = gqb; osc = QSC_B; } }
        const int row0 = rowbase + wr * 64 + fr, col0 = colt + wc * 32 + 8 * fq;
        if (hk == 0) {
#pragma unroll
            for (int ai = 0; ai < 2; ++ai)
#pragma unroll
                for (int m = 0; m < 4; ++m) { bf16_t* rowp = base + (size_t)(row0 + ai * HALF + m * 16) * ld + col0;
#pragma unroll
                    for (int bj = 0; bj < 2; ++bj) { f32x4 v0 = acc[ai][bj][m][0], v1 = acc[ai][bj][m][1];
                        if (sig) {
#pragma unroll
                            for (int j = 0; j < 4; ++j) { v0[j] = sigmoidf_(v0[j]); v1[j] = sigmoidf_(v1[j]); } }
                        u32x4 w; w.x = cvt_pk_bf16(v0[0], v0[1]); w.y = cvt_pk_bf16(v0[2], v0[3]); w.z = cvt_pk_bf16(v1[0], v1[1]); w.w = cvt_pk_bf16(v1[2], v1[3]);
                        *(u32x4*)(rowp + bj * HALF) = w; } }
            return;
        }
#pragma unroll
        for (int ai = 0; ai < 2; ++ai)
#pragma unroll
            for (int m = 0; m < 4; ++m)
#pragma unroll
                for (int bj = 0; bj < 2; ++bj) { const f32x4 v0 = acc[ai][bj][m][0], v1 = acc[ai][bj][m][1];
                    float sq = (v0[0] * v0[0] + v0[1] * v0[1]) + (v0[2] * v0[2] + v0[3] * v0[3]) + (v1[0] * v1[0] + v1[1] * v1[1]) + (v1[2] * v1[2] + v1[3] * v1[3]);
                    sq += __shfl_xor(sq, 16); sq += __shfl_xor(sq, 32);
                    if (fq == 0) X[((ai * HALF + wr * 64 + m * 16 + fr) * 2 + bj) * 4 + wc] = sq; }
        asm volatile("s_waitcnt lgkmcnt(0)" ::: "memory"); __builtin_amdgcn_s_barrier(); asm volatile("" ::: "memory");
        const bool h128 = (hk == 1), rope = u.pm < 64;
        const int t0 = h128 ? (16 * wc + 4 * fq) : (16 * (wc & 1) + 4 * fq);
        const int hd2 = h128 ? 64 : 32, nf = h128 ? 32 : 16;
        const bool userow = t0 < nf; const float inv_w = h128 ? (1.0f / 128) : (1.0f / 64);
#pragma unroll
        for (int ai = 0; ai < 2; ++ai)
#pragma unroll
            for (int m = 0; m < 4; ++m) { const int rt = ai * HALF + wr * 64 + m * 16 + fr;
                const int sp = (u.pm & 15) * BM + rt; const float pos = userow ? (float)(sp >> 6) : (float)(sp & 63);
                float cs[4], sn[4], ga[4], gb[4];
                { const float* gp = g + t0; asm volatile("" : "+v"(gp));
                  const f32x4 g1 = *(const f32x4*)gp, g2 = *(const f32x4*)(gp + hd2);
#pragma unroll
                  for (int p = 0; p < 4; ++p) { ga[p] = g1[p] * osc; gb[p] = g2[p] * osc; } }
#pragma unroll
                for (int p = 0; p < 4; ++p) { const float ang = pos * __builtin_amdgcn_exp2f(-(float)((t0 + p) & (nf - 1)) * (13.287712379549449f / (float)nf));
                    cs[p] = rope ? __cosf(ang) : 1.f; sn[p] = rope ? __sinf(ang) : 0.f; }
                bf16_t* rowp = base + (size_t)(rowbase + rt) * ld + col0;
#pragma unroll
                for (int bj = 0; bj < 2; ++bj) { const f32x4 xs = *(const LAS f32x4*)(X + (rt * 2 + bj) * 4);
                    const float tot = h128 ? ((xs[0] + xs[1]) + (xs[2] + xs[3])) : ((wc & 2) ? (xs[2] + xs[3]) : (xs[0] + xs[1]));
                    const float rstd = rsqrtf(tot * inv_w + EPS);
                    const f32x4 v0 = acc[ai][bj][m][0], v1 = acc[ai][bj][m][1];
                    float o[8]; const float e[8] = {v0[0], v0[1], v0[2], v0[3], v1[0], v1[1], v1[2], v1[3]};
#pragma unroll
                    for (int p = 0; p < 4; ++p) { const float x1 = e[2 * p] * rstd * ga[p], x2 = e[2 * p + 1] * rstd * gb[p];
                        o[2 * p] = x1 * cs[p] - x2 * sn[p]; o[2 * p + 1] = x2 * cs[p] + x1 * sn[p]; }
                    *(u32x4*)(rowp + bj * HALF) = pack8(o); }
                EPI_FENCE(); __builtin_amdgcn_sched_barrier(0); }
    }
};
template <int MODE> struct EpiBranch {
    bf16_t* T; const bf16_t* QG; int gcol0;
    __device__ __forceinline__ void operator()(const Acc& acc, const Unit& u, int wr, int wc, int fr, int fq) const {
        const int row0 = u.pm * BM + wr * 64 + fr, col0 = u.pn * BM + wc * 32 + 8 * fq;
#pragma unroll
        for (int ai = 0; ai < 2; ++ai)
#pragma unroll
            for (int m = 0; m < 4; ++m) { const int row = row0 + ai * HALF + m * 16;
#pragma unroll
                for (int bj = 0; bj < 2; ++bj) {
                    const u32x4 gw = *(const u32x4*)(QG + (size_t)row * QGW + gcol0 + col0 + bj * HALF);
                    float gt[8]; unpack8(gw, gt);
                    bf16_t* tp = T + (size_t)row * DM + col0 + bj * HALF;
                    float o[8];
                    const f32x4 v0 = acc[ai][bj][m][0], v1 = acc[ai][bj][m][1];
#pragma unroll
                    for (int j = 0; j < 4; ++j) { o[j] = gt[j] * v0[j]; o[4 + j] = gt[4 + j] * v1[j]; }
                    if (MODE == 1) { const u32x4 tw = *(const u32x4*)tp; float tv[8]; unpack8(tw, tv);
#pragma unroll
                        for (int j = 0; j < 8; ++j) o[j] += tv[j]; }
                    *(u32x4*)tp = pack8(o); }
                EPI_FENCE(); }
    }
};
struct EpiResid {
    const float* base; float* out; const float* gate;
    __device__ __forceinline__ void operator()(const Acc& acc, const Unit& u, int wr, int wc, int fr, int fq) const {
        const int row0 = u.pm * BM + wr * 64 + fr, col0 = u.pn * BM + wc * 32 + 8 * fq;
        const float* gp = gate + (size_t)(u.pm >> 4) * ADAW + col0;
        f32x4 gv[2][2];
#pragma unroll
        for (int bj = 0; bj < 2; ++bj) { gv[bj][0] = *(const f32x4*)(gp + bj * HALF); gv[bj][1] = *(const f32x4*)(gp + bj * HALF + 4); }
#pragma unroll
        for (int ai = 0; ai < 2; ++ai)
#pragma unroll
            for (int m = 0; m < 4; ++m) { const size_t off = (size_t)(row0 + ai * HALF + m * 16) * DM + col0;
#pragma unroll
                for (int bj = 0; bj < 2; ++bj) {
                    const f32x4 b0 = *(const f32x4*)(base + off + bj * HALF), b1 = *(const f32x4*)(base + off + bj * HALF + 4);
                    *(f32x4*)(out + off + bj * HALF) = b0 + gv[bj][0] * acc[ai][bj][m][0];
                    *(f32x4*)(out + off + bj * HALF + 4) = b1 + gv[bj][1] * acc[ai][bj][m][1]; }
                EPI_FENCE(); }
    }
};
struct EpiSwiglu {
    bf16_t* HM;
    __device__ __forceinline__ void operator()(const Acc& acc, const Unit& u, int wr, int wc, int fr, int fq) const {
        const int row0 = u.pm * BM + wr * 64 + fr, col0 = u.pn * HALF + wc * 32 + 8 * fq;
#pragma unroll
        for (int ai = 0; ai < 2; ++ai)
#pragma unroll
            for (int m = 0; m < 4; ++m) { float o[8];
#pragma unroll
                for (int n = 0; n < 2; ++n)
#pragma unroll
                    for (int j = 0; j < 4; ++j) { const float gg = acc[ai][0][m][n][j], uu = acc[ai][1][m][n][j]; o[4 * n + j] = gg * sigmoidf_(gg) * uu; }
                *(u32x4*)(HM + (size_t)(row0 + ai * HALF + m * 16) * DFF + col0) = pack8(o); }
    }
};
}

namespace att {
constexpr int NW = 8, QBLK = 32, KVBLK = 64, DV = 128, LDK = KVW;
constexpr int SHM_V = KVBLK * DV * 2;
constexpr int OFF_K = 2 * SHM_V, OFF_WS = 65536, OFF_Q = OFF_WS + 2048;
constexpr float THR = 8.f;
#define SBAR() __builtin_amdgcn_sched_barrier(0)
__device__ __forceinline__ int crow(int r, int hi) { return (r & 3) + 8 * (r >> 2) + 4 * hi; }
template <int DQK> __device__ __forceinline__ int kswz(int row, int colB) {
    if (DQK == 128) return row * 256 + (colB ^ ((row & 15) << 4));
    else return row * 128 + (colB ^ (((row >> 1) & 7) << 4));
}
template <bool FAST> __device__ __forceinline__ void partialSM(f32x16& p0, f32x16& p1, float& m_reg, float& mn, float& alpha) {
    if (!FAST) {
        constexpr float THR2 = THR * 1.4426950408889634f;
        float pmax = p0[0];
#pragma unroll
        for (int r = 1; r < 16; ++r) pmax = fmaxf(pmax, p0[r]);
#pragma unroll
        for (int r = 0; r < 16; ++r) pmax = fmaxf(pmax, p1[r]);
        { auto rr = __builtin_amdgcn_permlane32_swap(__float_as_uint(pmax), __float_as_uint(pmax), false, false);
          pmax = fmaxf(__uint_as_float(rr[0]), __uint_as_float(rr[1])); }
        if (__builtin_expect(__all(pmax - m_reg <= THR2), 1)) { mn = m_reg; alpha = 1.f; }
        else { mn = fmaxf(m_reg, pmax); alpha = __builtin_amdgcn_exp2f(m_reg - mn); m_reg = mn; }
#pragma unroll
        for (int r = 0; r < 16; ++r) p0[r] = p0[r] - mn;
#pragma unroll
        for (int r = 0; r < 16; ++r) p1[r] = p1[r] - mn;
    }
    if (FAST) SBAR();
#pragma unroll
    for (int r = 0; r < 16; ++r) p0[r] = __builtin_amdgcn_exp2f(p0[r]);
    if (FAST) SBAR();
}
template <bool FAST> __device__ __forceinline__ void finishSM(f32x16& p0, f32x16& p1, float alpha, float& l_reg, bf16x8& pa0, bf16x8& pa1, bf16x8& pa2, bf16x8& pa3) {
    if (FAST) SBAR();
#pragma unroll
    for (int r = 0; r < 16; ++r) p1[r] = __builtin_amdgcn_exp2f(p1[r]);
    float ps = 0;
    if (FAST) { float s0 = 0.f, s1 = 0.f, s2 = 0.f, s3 = 0.f;
#pragma unroll
        for (int r = 0; r < 16; r += 4) { s0 += p0[r] + p1[r]; s1 += p0[r + 1] + p1[r + 1]; s2 += p0[r + 2] + p1[r + 2]; s3 += p0[r + 3] + p1[r + 3]; }
        ps = (s0 + s1) + (s2 + s3); }
    else {
#pragma unroll
    for (int r = 0; r < 16; ++r) ps += p0[r];
#pragma unroll
    for (int r = 0; r < 16; ++r) ps += p1[r];
    }
    if (FAST) { SBAR(); l_reg += ps; }
    else { auto rr = __builtin_amdgcn_permlane32_swap(__float_as_uint(ps), __float_as_uint(ps), false, false);
           ps = __uint_as_float(rr[0]) + __uint_as_float(rr[1]); l_reg = l_reg * alpha + ps; }
#define PK4(P, BASE, OUT) do { unsigned a0 = cvt_pk_bf16(P[BASE + 0], P[BASE + 1]), a1 = cvt_pk_bf16(P[BASE + 2], P[BASE + 3]);   \
    unsigned b0 = cvt_pk_bf16(P[BASE + 4], P[BASE + 5]), b1 = cvt_pk_bf16(P[BASE + 6], P[BASE + 7]);                              \
    auto r0 = __builtin_amdgcn_permlane32_swap(a0, b0, false, false); auto r1 = __builtin_amdgcn_permlane32_swap(a1, b1, false, false); \
    u32x4 w = {r0[0], r1[0], r0[1], r1[1]}; OUT = __builtin_bit_cast(bf16x8, w); } while (0)
    PK4(p0, 0, pa0); PK4(p0, 8, pa1); PK4(p1, 0, pa2); PK4(p1, 8, pa3);
#undef PK4
}
template <int DQK> __device__ __forceinline__ void qkt(f32x16& p0, f32x16& p1, const char* Ks, const bf16x8* qr, int r32, int hi) {
    p0 = f32x16{}; p1 = f32x16{};
#pragma unroll
    for (int d0 = 0; d0 < DQK / 16; ++d0) { const int cb = (d0 * 16 + hi * 8) * 2, ci = 0;
        const bf16x8 b0 = *reinterpret_cast<const bf16x8*>(Ks + kswz<DQK>(r32, cb) + ci);
        const bf16x8 b1 = *reinterpret_cast<const bf16x8*>(Ks + kswz<DQK>(r32, cb) + ci + 32 * (DQK * 2));
        p0 = __builtin_amdgcn_mfma_f32_32x32x16_bf16(b0, qr[d0], p0, 0, 0, 0);
        p1 = __builtin_amdgcn_mfma_f32_32x32x16_bf16(b1, qr[d0], p1, 0, 0, 0); }
}
template <int DQK, int NREG> __device__ __forceinline__ void qkt_mix(f32x16& p0, f32x16& p1, const char* Ks, const bf16x8* qr, const char* qs, int r32, int hi) {
    p0 = f32x16{}; p1 = f32x16{};
#pragma unroll
    for (int d0 = 0; d0 < DQK / 16; ++d0) { const int cb = (d0 * 16 + hi * 8) * 2, ci = 0;
        const bf16x8 b0 = *reinterpret_cast<const bf16x8*>(Ks + kswz<DQK>(r32, cb) + ci);
        const bf16x8 b1 = *reinterpret_cast<const bf16x8*>(Ks + kswz<DQK>(r32, cb) + ci + 32 * (DQK * 2));
        bf16x8 q; if (d0 < NREG) q = qr[d0]; else q = *reinterpret_cast<const bf16x8*>(qs + (d0 - NREG) * 1024);
        p0 = __builtin_amdgcn_mfma_f32_32x32x16_bf16(b0, q, p0, 0, 0, 0);
        p1 = __builtin_amdgcn_mfma_f32_32x32x16_bf16(b1, q, p1, 0, 0, 0); }
}
template <int DQK> __device__ __forceinline__ void qkt_ld(f32x16& p0, f32x16& p1, const char* Ks, const bf16_t* qw, int r32, int hi) {
    p0 = f32x16{}; p1 = f32x16{};
#pragma unroll
    for (int d0 = 0; d0 < DQK / 16; ++d0) { const int cb = (d0 * 16 + hi * 8) * 2, ci = 0;
        const bf16x8 q = *(const bf16x8*)(qw + d0 * 16);
        const bf16x8 b0 = *reinterpret_cast<const bf16x8*>(Ks + kswz<DQK>(r32, cb) + ci);
        const bf16x8 b1 = *reinterpret_cast<const bf16x8*>(Ks + kswz<DQK>(r32, cb) + ci + 32 * (DQK * 2));
        p0 = __builtin_amdgcn_mfma_f32_32x32x16_bf16(b0, q, p0, 0, 0, 0);
        p1 = __builtin_amdgcn_mfma_f32_32x32x16_bf16(b1, q, p1, 0, 0, 0); SBAR(); }
}
__device__ __forceinline__ int v_st(int k, int c) { const int kk = (k & ~0xC) | ((k & 4) << 1) | ((k & 8) >> 1); return ((kk >> 3) * 4 + (c >> 5)) * 512 + ((kk & 7) * 32 + (c & 31)) * 2; }
__device__ __forceinline__ int v_rd_base(int lane) { return ((lane & 3) << 3) | (((lane >> 2) & 3) << 6) | (((lane >> 4) & 1) << 5) | (((lane >> 5) & 1) << 8); }
constexpr int v_rd_off(int d0, int ks, int half) { return d0 * 512 + ks * 4096 + half * 2048; }
template <int OFF> __device__ __forceinline__ s16x4 tr_read(int vb) {
    s16x4 r; asm volatile("ds_read_b64_tr_b16 %0, %1 offset:%2" : "=&v"(r) : "v"(vb), "i"(OFF) : "memory"); return r;
}
template <int D0> __device__ __forceinline__ void pv_one(f32x16& od, int vb, bf16x8 pa0, bf16x8 pa1, bf16x8 pa2, bf16x8 pa3) {
    const s16x4 l0 = tr_read<v_rd_off(D0, 0, 0)>(vb), h0 = tr_read<v_rd_off(D0, 0, 1)>(vb), l1 = tr_read<v_rd_off(D0, 1, 0)>(vb), h1 = tr_read<v_rd_off(D0, 1, 1)>(vb);
    const s16x4 l2 = tr_read<v_rd_off(D0, 2, 0)>(vb), h2 = tr_read<v_rd_off(D0, 2, 1)>(vb), l3 = tr_read<v_rd_off(D0, 3, 0)>(vb), h3 = tr_read<v_rd_off(D0, 3, 1)>(vb);
    asm volatile("s_waitcnt lgkmcnt(0)" ::: "memory"); SBAR();
#define PK(L, H) (bf16x8){L[0], L[1], L[2], L[3], H[0], H[1], H[2], H[3]}
    od = __builtin_amdgcn_mfma_f32_32x32x16_bf16(pa0, PK(l0, h0), od, 0, 0, 0);
    od = __builtin_amdgcn_mfma_f32_32x32x16_bf16(pa1, PK(l1, h1), od, 0, 0, 0);
    od = __builtin_amdgcn_mfma_f32_32x32x16_bf16(pa2, PK(l2, h2), od, 0, 0, 0);
    od = __builtin_amdgcn_mfma_f32_32x32x16_bf16(pa3, PK(l3, h3), od, 0, 0, 0);
#undef PK
}
__device__ __forceinline__ void pv_d0(f32x16* o, int vb, bf16x8 pa0, bf16x8 pa1, bf16x8 pa2, bf16x8 pa3) {
    pv_one<0>(o[0], vb, pa0, pa1, pa2, pa3); pv_one<1>(o[1], vb, pa0, pa1, pa2, pa3); pv_one<2>(o[2], vb, pa0, pa1, pa2, pa3); pv_one<3>(o[3], vb, pa0, pa1, pa2, pa3);
}

template <int DQK, int LDQ, int LDO, bool FAST, int SD>
__device__ __forceinline__ void attn_unit(const bf16_t* Qb, const bf16_t* __restrict__ Kh, const bf16_t* __restrict__ Vh, bf16_t* Ob,
                                          char* lds) {
    constexpr int SHM_K = KVBLK * DQK * 2, ND0 = DQK / 16;
    int tid_ = threadIdx.x; asm volatile("" : "+v"(tid_));
    const int tid = tid_, wid = tid >> 6, lane = tid & 63, r32 = lane & 31, hi = lane >> 5;
    char* V_lds = lds; char* K_lds = lds + OFF_K;
    float* ws = (float*)(lds + OFF_WS) + wid * 64; float* li_l = ws; float* al_l = ws + 32;
    float m_reg = -1e30f, l_reg = 0; f32x16 o[4] = {};
    const bf16_t* Qw0 = Qb + (size_t)(wid * QBLK + r32) * LDQ + hi * 8;
#define QLOAD() const bf16_t* qw_ = Qw0; asm volatile("" : "+v"(qw_))
    const int sr = tid >> 4, sc = (tid & 15) * 8, vst0 = v_st(sr, sc), vst1 = v_st(32 + sr, sc);
    const int krow = (DQK == 128) ? sr : (tid >> 3), kcol = (DQK == 128) ? sc : (tid & 7) * 8;
    const int kst0 = kswz<DQK>(krow, kcol * 2), kst1 = kswz<DQK>(32 + krow, kcol * 2);
    const int vb0 = (int)(uintptr_t)V_lds + v_rd_base(lane);
    struct { bf16x8 vs0, vs1, ks0, ks1; } sr_[SD];
#define SLOAD(i, k0) do { sr_[i].vs0 = *(const bf16x8*)(&Vh[(size_t)((k0) + sr) * LDK + sc]); sr_[i].vs1 = *(const bf16x8*)(&Vh[(size_t)((k0) + 32 + sr) * LDK + sc]); \
    sr_[i].ks0 = *(const bf16x8*)(&Kh[(size_t)((k0) + krow) * LDK + kcol]); if (DQK == 128) sr_[i].ks1 = *(const bf16x8*)(&Kh[(size_t)((k0) + 32 + krow) * LDK + kcol]); } while (0)
#define SWRITE(b, i) do { *(bf16x8*)(V_lds + (b) * SHM_V + vst0) = sr_[i].vs0; *(bf16x8*)(V_lds + (b) * SHM_V + vst1) = sr_[i].vs1; \
    *(bf16x8*)(K_lds + (b) * SHM_K + kst0) = sr_[i].ks0; if (DQK == 128) *(bf16x8*)(K_lds + (b) * SHM_K + kst1) = sr_[i].ks1; } while (0)
#define SWAIT() do { if (SD == 1) asm volatile("s_waitcnt vmcnt(0)" ::: "memory"); else if (DQK == 128) asm volatile("s_waitcnt vmcnt(4)" ::: "memory"); else asm volatile("s_waitcnt vmcnt(3)" ::: "memory"); } while (0)
#define RESC(a) do { if (!FAST && __any((a) < 1.f)) { if (hi == 0) al_l[r32] = (a); asm volatile("s_waitcnt lgkmcnt(0)" ::: "memory"); \
    _Pragma("unroll") for (int d = 0; d < 4; ++d) _Pragma("unroll") for (int r = 0; r < 16; ++r) o[d][r] *= al_l[crow(r, hi)]; } } while (0)
    f32x16 pA0, pA1, pB0, pB1; float mnA, mnB, alA, alB; bf16x8 pa0, pa1, pa2, pa3; constexpr int NT = SKV / KVBLK;
    constexpr int SE = 0, SO = SD - 1;
    SLOAD(SE, 0); asm volatile("s_waitcnt vmcnt(0)" ::: "memory"); SWRITE(0, SE); __syncthreads();
    { QLOAD(); qkt_ld<DQK>(pA0, pA1, K_lds, qw_, r32, hi); } partialSM<FAST>(pA0, pA1, m_reg, mnA, alA);
    SLOAD(SO, KVBLK); if (SD == 2) SLOAD(SE, 2 * KVBLK);
    SWAIT(); SWRITE(1, SO); __syncthreads();
    for (int j = 1; j + 1 < NT; j += 2) {
        SBAR(); { QLOAD(); qkt_ld<DQK>(pB0, pB1, K_lds + SHM_K, qw_, r32, hi); }
        finishSM<FAST>(pA0, pA1, alA, l_reg, pa0, pa1, pa2, pa3); SBAR();
        SLOAD(SO, (j + SD) * KVBLK); SBAR();
        pv_d0(o, vb0, pa0, pa1, pa2, pa3); partialSM<FAST>(pB0, pB1, m_reg, mnB, alB);
        __syncthreads(); SWAIT(); SWRITE(0, SE);
        RESC(alB); __syncthreads();
        SBAR(); { QLOAD(); qkt_ld<DQK>(pA0, pA1, K_lds, qw_, r32, hi); }
        finishSM<FAST>(pB0, pB1, alB, l_reg, pa0, pa1, pa2, pa3); SBAR();
        if (SD == 1 || j + 3 < NT) SLOAD(SE, (j + 1 + SD) * KVBLK); SBAR();
        pv_d0(o, vb0 + SHM_V, pa0, pa1, pa2, pa3); partialSM<FAST>(pA0, pA1, m_reg, mnA, alA);
        __syncthreads(); SWAIT(); SWRITE(1, SO);
        RESC(alA); __syncthreads();
    }
    SBAR(); { QLOAD(); qkt_ld<DQK>(pB0, pB1, K_lds + SHM_K, qw_, r32, hi); }
    finishSM<FAST>(pA0, pA1, alA, l_reg, pa0, pa1, pa2, pa3); SBAR();
    pv_d0(o, vb0, pa0, pa1, pa2, pa3); partialSM<FAST>(pB0, pB1, m_reg, mnB, alB);
    __syncthreads(); RESC(alB);
    finishSM<FAST>(pB0, pB1, alB, l_reg, pa0, pa1, pa2, pa3); SBAR();
    pv_d0(o, vb0 + SHM_V, pa0, pa1, pa2, pa3);
    if (FAST) { auto rr = __builtin_amdgcn_permlane32_swap(__float_as_uint(l_reg), __float_as_uint(l_reg), false, false); l_reg = __uint_as_float(rr[0]) + __uint_as_float(rr[1]); }
    if (hi == 0) li_l[r32] = l_reg; asm volatile("s_waitcnt lgkmcnt(0)" ::: "memory");
    float rli[16];
#pragma unroll
    for (int r = 0; r < 16; ++r) rli[r] = __builtin_amdgcn_rcpf(li_l[crow(r, hi)]);
    __syncthreads();
    {
        bf16_t* stg = (bf16_t*)lds + wid * 4096;
#pragma unroll
        for (int r = 0; r < 16; ++r) { const int orow = crow(r, hi);
#pragma unroll
            for (int d0 = 0; d0 < 4; ++d0) { const float v = o[d0][r] * rli[r]; stg[orow * 128 + d0 * 32 + r32] = (bf16_t)(cvt_pk_bf16(v, v) & 0xffffu); } }
        asm volatile("s_waitcnt lgkmcnt(0)" ::: "memory");
        bf16_t* Ow = Ob + (size_t)(wid * QBLK) * LDO;
#pragma unroll
        for (int i = 0; i < 8; ++i) { const int row = i * 4 + (lane >> 4), ch = lane & 15; const u32x4 v = *(const u32x4*)(stg + row * 128 + ch * 8);
            *(u32x4*)(Ow + (size_t)row * LDO + ch * 8) = v; }
    }
    __syncthreads();
#undef QLOAD
#undef SLOAD
#undef SWRITE
#undef SWAIT
#undef RESC
}

__device__ __forceinline__ void glds16(const void* gsrc, unsigned lds_dst) { unsigned keep;
    asm volatile("s_mov_b32 %0, m0\n\ts_mov_b32 m0, %2\n\ts_nop 0\n\tglobal_load_lds_dwordx4 %1, off\n\ts_mov_b32 m0, %0" : "=&s"(keep) : "v"(gsrc), "s"(lds_dst) : "memory"); }
template <int DQK, int LDQ, int LDO>
__device__ __forceinline__ void attn_unit_fast(const bf16_t* Qb, const bf16_t* __restrict__ Kh, const bf16_t* __restrict__ Vh, bf16_t* Ob, char* lds,
                                               int mode = 0, float lam = 0.f, const float* __restrict__ sg = nullptr) {
    constexpr int SHM_K = KVBLK * DQK * 2, ND0 = DQK / 16, NT = SKV / KVBLK;
    constexpr int NQL = (DQK == 128) ? 2 : 0, NREG = ND0 - NQL;
    constexpr bool EARLY = (DQK == 64);
    static_assert(NT % 2 == 0 && NT >= 4, "even tile count");
    int tid_ = threadIdx.x; if (DQK == 128) asm volatile("" : "+v"(tid_));
    const int tid = tid_, wid = tid >> 6, lane = tid & 63, r32 = lane & 31, hi = lane >> 5;
    const bool isY = false;
    char* V_lds = lds; char* K_lds = lds + OFF_K;
    float l_reg = 0, dummy_m = 0, dummy_a = 1.f; f32x16 o[4] = {}; bf16x8 qr[NREG];
    char* qs = lds + OFF_Q + wid * (2 * 1024) + lane * 16;
    {
        const bf16_t* Qw = Qb + (size_t)(wid * QBLK + r32) * LDQ + hi * 8;
#pragma unroll
        for (int d0 = 0; d0 < NREG; ++d0) qr[d0] = *(const bf16x8*)(Qw + d0 * 16);
#pragma unroll
        for (int d0 = NREG; d0 < ND0; ++d0) *(bf16x8*)(qs + (d0 - NREG) * 1024) = *(const bf16x8*)(Qw + d0 * 16);
    }
    const int widu = __builtin_amdgcn_readfirstlane(wid);
    const int vb0 = (int)(uintptr_t)V_lds + v_rd_base(lane);
    unsigned ksrc[2], vsrc[2];
#pragma unroll
    for (int i = 0; i < 2; ++i) {
        if (DQK == 128) { const int j = wid * 2 + i, row = 4 * j + (lane >> 4), c = (lane & 15) ^ (row & 15); ksrc[i] = (unsigned)(row * LDK + c * 8) * 2u; }
        else { const int row = 8 * wid + (lane >> 3), c = (lane & 7) ^ ((row >> 1) & 7); ksrc[i] = (unsigned)(row * LDK + c * 8) * 2u; }
        const int j = wid * 2 + i, st = 2 * j + (lane >> 5), kk = (st >> 2) * 8 + ((lane & 31) >> 2), c = (st & 3) * 32 + (lane & 3) * 8;
        const int k = (kk & ~0xC) | ((kk & 4) << 1) | ((kk & 8) >> 1);
        vsrc[i] = (unsigned)(k * LDK + c) * 2u;
    }
    constexpr size_t TILEB = (size_t)KVBLK * LDK * 2;
    const unsigned lds0 = (unsigned)(uintptr_t)lds;
#define DMA_K(t, buf) do { const char* kb_ = (const char*)Kh + (size_t)(t) * TILEB; \
        glds16(kb_ + ksrc[0], (unsigned)__builtin_amdgcn_readfirstlane(lds0 + OFF_K + (buf) * SHM_K + (DQK == 128 ? widu * 2048 : widu * 1024))); \
        if (DQK == 128) glds16(kb_ + ksrc[1], (unsigned)__builtin_amdgcn_readfirstlane(lds0 + OFF_K + (buf) * SHM_K + widu * 2048 + 1024)); } while (0)
#define DMA_V(t, buf) do { const char* vb_ = (const char*)Vh + (size_t)(t) * TILEB; \
        glds16(vb_ + vsrc[0], (unsigned)__builtin_amdgcn_readfirstlane(lds0 + (buf) * SHM_V + widu * 2048)); \
        glds16(vb_ + vsrc[1], (unsigned)__builtin_amdgcn_readfirstlane(lds0 + (buf) * SHM_V + widu * 2048 + 1024)); } while (0)
#define WBAR0() do { asm volatile("s_waitcnt vmcnt(0)" ::: "memory"); __syncthreads(); } while (0)
#define EXPH(P) do { _Pragma("unroll") for (int r = 0; r < 16; ++r) P[r] = __builtin_amdgcn_exp2f(P[r]); } while (0)
    f32x16 pA0, pA1, pB0, pB1; bf16x8 pa0, pa1, pa2, pa3;
    DMA_K(0, 0); WBAR0();
    if (__builtin_amdgcn_readfirstlane(tid_) >= 256) __builtin_amdgcn_s_setprio(1);
    DMA_K(1, 1); DMA_V(0, 0); SBAR();
    qkt_mix<DQK, NREG>(pA0, pA1, K_lds, qr, qs, r32, hi); if (!isY) { EXPH(pA0); }
    WBAR0();
    for (int k = 1; k + 1 < NT; k += 2) {
        DMA_K(k + 1, 0); DMA_V(k, 1); SBAR();
        if (isY) { EXPH(pA0); }
        SBAR(); qkt_mix<DQK, NREG>(pB0, pB1, K_lds + SHM_K, qr, qs, r32, hi);
        finishSM<true>(pA0, pA1, dummy_a, l_reg, pa0, pa1, pa2, pa3); SBAR();
        pv_d0(o, vb0, pa0, pa1, pa2, pa3);
        if (!isY) { EXPH(pB0); }
        WBAR0();
        DMA_K(k + 2, 1); DMA_V(k + 1, 0); SBAR();
        if (isY) { EXPH(pB0); }
        SBAR(); qkt_mix<DQK, NREG>(pA0, pA1, K_lds, qr, qs, r32, hi);
        finishSM<true>(pB0, pB1, dummy_a, l_reg, pa0, pa1, pa2, pa3); SBAR();
        pv_d0(o, vb0 + SHM_V, pa0, pa1, pa2, pa3);
        if (!isY) { EXPH(pA0); }
        WBAR0();
    }
    DMA_V(NT - 1, 1); SBAR();
    if (isY) { EXPH(pA0); }
    SBAR(); qkt_mix<DQK, NREG>(pB0, pB1, K_lds + SHM_K, qr, qs, r32, hi);
    finishSM<true>(pA0, pA1, dummy_a, l_reg, pa0, pa1, pa2, pa3); SBAR();
    pv_d0(o, vb0, pa0, pa1, pa2, pa3);
    if (!isY) { EXPH(pB0); }
    WBAR0();
    if (isY) { EXPH(pB0); }
    SBAR(); finishSM<true>(pB0, pB1, dummy_a, l_reg, pa0, pa1, pa2, pa3); SBAR();
    pv_d0(o, vb0 + SHM_V, pa0, pa1, pa2, pa3);
    __builtin_amdgcn_s_setprio(0);
    (void)dummy_m;
    { auto rr = __builtin_amdgcn_permlane32_swap(__float_as_uint(l_reg), __float_as_uint(l_reg), false, false); l_reg = __uint_as_float(rr[0]) + __uint_as_float(rr[1]); }
    {
        int t2 = threadIdx.x; asm volatile("" : "+v"(t2));
        const int wid2 = t2 >> 6, lane2 = t2 & 63, r32b = lane2 & 31, hib = lane2 >> 5;
        float* li2 = (float*)(lds + OFF_WS) + wid2 * 64;
        if (hib == 0) li2[r32b] = l_reg; asm volatile("s_waitcnt lgkmcnt(0)" ::: "memory");
        __syncthreads();
        bf16_t* stash = (bf16_t*)(lds + OFF_Q) + wid2 * 4096;
        bf16_t* stg = (mode == 1) ? stash : ((bf16_t*)lds + wid2 * 4096);
#pragma unroll
        for (int r = 0; r < 16; ++r) { const int orow = crow(r, hib); const float rl = __builtin_amdgcn_rcpf(li2[orow]);
#pragma unroll
            for (int d0 = 0; d0 < 4; ++d0) { const float v = o[d0][r] * rl; stg[orow * 128 + d0 * 32 + r32b] = (bf16_t)(cvt_pk_bf16(v, v) & 0xffffu); } }
        asm volatile("s_waitcnt lgkmcnt(0)" ::: "memory");
        if (mode != 1) {
            bf16_t* Ow = Ob + (size_t)(wid2 * QBLK) * LDO;
            const int ch = lane2 & 15;
            float gg[8];
            if (mode == 2) {
#pragma unroll
                for (int e = 0; e < 8; ++e) gg[e] = sg[ch * 8 + e] * 0.8f; }
#pragma unroll
            for (int i = 0; i < 8; ++i) { const int row = i * 4 + (lane2 >> 4); u32x4 v = *(const u32x4*)(stg + row * 128 + ch * 8);
                if (mode == 2) { const u32x4 v0 = *(const u32x4*)(stash + row * 128 + ch * 8); float x0[8], x1[8]; unpack8(v0, x0); unpack8(v, x1); float ss = 0.f;
#pragma unroll
                    for (int e = 0; e < 8; ++e) { x0[e] = x0[e] - lam * x1[e]; ss += x0[e] * x0[e]; }
                    ss += __shfl_xor(ss, 1); ss += __shfl_xor(ss, 2); ss += __shfl_xor(ss, 4); ss += __shfl_xor(ss, 8);
                    const float rstd = rsqrtf(ss * (1.0f / 128) + EPS);
#pragma unroll
                    for (int e = 0; e < 8; ++e) x0[e] = x0[e] * rstd * gg[e];
                    v = pack8(x0); }
                *(u32x4*)(Ow + (size_t)row * LDO + ch * 8) = v; }
        }
    }
    asm volatile("s_waitcnt vmcnt(0)" ::: "memory");
    __syncthreads();
#undef DMA_K
#undef DMA_V
#undef WBAR0
#undef EXPH
}
#undef SBAR
}

struct Args { const float* in[24]; float* out; unsigned char* ws; int ph_lo, ph_hi; };
enum { I_X = 0, I_C, I_CTX, I_CCTX, I_WADA, I_BADA, I_N1G, I_WIN, I_QNA, I_KNA, I_QNB, I_KNB, I_LQ1, I_LK1, I_LQ2, I_LK2, I_SUBLN, I_WBRA, I_WBRB, I_WOUT, I_N2G, I_WFG, I_WFU, I_WFD };
constexpr int NPHASES = 11;

__device__ __forceinline__ void transpose_item(const float* W, int K, int N, bf16_t* WT, int gu, LAS float* scr, int item, int lane) {
    const int nblk = N / 32, kb = item / nblk, nb = item % nblk, k0 = 64 * kb, n0 = 32 * nb;
#pragma unroll 8
    for (int i = 0; i < 32; ++i) { const int kk = 2 * i + (lane >> 5); scr[kk * 33 + (lane & 31)] = W[(size_t)(k0 + kk) * N + n0 + (lane & 31)]; }
    asm volatile("s_waitcnt lgkmcnt(0)" ::: "memory");
    const int c = lane & 7;
    const int rbase = (gu == 0 || gu == 3) ? n0 : (((n0 >> 7) << 8) + (n0 & 127) + (gu == 2 ? 128 : 0));
    const int hk = (gu != 3) ? 0 : ((n0 < 512 || (n0 >= 3072 && n0 < 5120)) ? 1 : (((n0 >= 1024 && n0 < 2048) || (n0 >= 5120 && n0 < 6144)) ? 2 : 0));
#pragma unroll
    for (int j = 0; j < 4; ++j) { const int n = (lane >> 3) + 8 * j; const LAS float* s = scr + (8 * c) * 33 + n;
        int rown = rbase + n;
        if (hk == 1) { const int i = (n0 & 127) + n; rown = (n0 & ~127) + ((i < 64) ? 2 * i : 2 * (i - 64) + 1); }
        else if (hk == 2) { const int i = (n0 & 63) + n; rown = (n0 & ~63) + ((i < 32) ? 2 * i : 2 * (i - 32) + 1); }
        u32x4 o; o.x = cvt_pk_bf16(s[0 * 33], s[1 * 33]); o.y = cvt_pk_bf16(s[2 * 33], s[3 * 33]); o.z = cvt_pk_bf16(s[4 * 33], s[5 * 33]); o.w = cvt_pk_bf16(s[6 * 33], s[7 * 33]);
        *(u32x4*)(WT + (size_t)rown * K + k0 + 8 * c) = o; }
    asm volatile("s_waitcnt lgkmcnt(0)" ::: "memory");
}

__device__ __forceinline__ void norm_chunk(const float* X, bf16_t* OUT, int row0, const LAS float* mA, const LAS float* mS, int wave, int lane, int rpw = 8) {
    for (int r = 0; r < rpw; ++r) {
        const int row = row0 + wave * rpw + r;
        const f32x4* xr = (const f32x4*)(X + (size_t)row * DM) + lane;
        f32x4 v[8]; float ss = 0.f;
#pragma unroll
        for (int j = 0; j < 8; ++j) { v[j] = xr[64 * j]; ss += (v[j].x * v[j].x + v[j].y * v[j].y) + (v[j].z * v[j].z + v[j].w * v[j].w); }
        ss = wave_sum(ss);
        const float rstd = rsqrtf(ss * (1.0f / DM) + EPS);
        u32x2* op = (u32x2*)(OUT + (size_t)row * DM) + lane;
#pragma unroll
        for (int j = 0; j < 8; ++j) { const int col = 4 * lane + 256 * j; const f32x4 a = *(const LAS f32x4*)(mA + col), s = *(const LAS f32x4*)(mS + col);
            const f32x4 ov = v[j] * rstd * a + s; u32x2 w; w.x = cvt_pk_bf16(ov.x, ov.y); w.y = cvt_pk_bf16(ov.z, ov.w); op[64 * j] = w; }
    }
}

__device__ __forceinline__ void nr128(bf16_t* p, const float* g, bool rope, float prow, float pcol, int lane, float osc) {
    const u32x4 raw = *(const u32x4*)p; float x[8]; unpack8(raw, x); float ss = 0.f;
#pragma unroll
    for (int e = 0; e < 8; ++e) ss += x[e] * x[e];
    ss += __shfl_xor(ss, 1); ss += __shfl_xor(ss, 2); ss += __shfl_xor(ss, 4); ss += __shfl_xor(ss, 8);
    const float rstd = rsqrtf(ss * (1.0f / 128) + EPS); const int idx0 = (lane & 15) * 8;
#pragma unroll
    for (int e = 0; e < 8; ++e) x[e] = x[e] * rstd * g[idx0 + e];
    if (rope) { const bool lo_half = (lane & 8) == 0; const int i0 = idx0 & 63;
#pragma unroll
        for (int e = 0; e < 8; ++e) { const float pp = __shfl_xor(x[e], 8); const int i = i0 + e, f = i & 31;
            const float ang = ((i < 32) ? prow : pcol) * __builtin_amdgcn_exp2f(-(float)f * (13.287712379549449f / 32));
            const float c = __cosf(ang), sn = __sinf(ang);
            x[e] = lo_half ? (x[e] * c - pp * sn) : (x[e] * c + pp * sn); } }
#pragma unroll
    for (int e = 0; e < 8; ++e) x[e] *= osc;
    *(u32x4*)p = pack8(x);
}
__device__ __forceinline__ void nr64(bf16_t* p, const float* g, bool rope, float prow, float pcol, int lane, float osc) {
    const u32x4 raw = *(const u32x4*)p; float x[8]; unpack8(raw, x); float ss = 0.f;
#pragma unroll
    for (int e = 0; e < 8; ++e) ss += x[e] * x[e];
    ss += __shfl_xor(ss, 1); ss += __shfl_xor(ss, 2); ss += __shfl_xor(ss, 4);
    const float rstd = rsqrtf(ss * (1.0f / 64) + EPS); const int idx0 = (lane & 7) * 8;
#pragma unroll
    for (int e = 0; e < 8; ++e) x[e] = x[e] * rstd * g[idx0 + e];
    if (rope) { const bool lo_half = (lane & 4) == 0; const int i0 = idx0 & 31;
#pragma unroll
        for (int e = 0; e < 8; ++e) { const float pp = __shfl_xor(x[e], 4); const int i = i0 + e, f = i & 15;
            const float ang = ((i < 16) ? prow : pcol) * __builtin_amdgcn_exp2f(-(float)f * (13.287712379549449f / 16));
            const float c = __cosf(ang), sn = __sinf(ang);
            x[e] = lo_half ? (x[e] * c - pp * sn) : (x[e] * c + pp * sn); } }
#pragma unroll
    for (int e = 0; e < 8; ++e) x[e] *= osc;
    *(u32x4*)p = pack8(x);
}

__device__ __forceinline__ void light_grid_barrier(unsigned* ctr, unsigned target) {
    asm volatile("s_waitcnt vmcnt(0)" ::: "memory");
    __syncthreads();
    if (threadIdx.x == 0) {
        __builtin_amdgcn_fence(__ATOMIC_RELEASE, "agent");
        asm volatile("s_waitcnt vmcnt(0)" ::: "memory");
        (void)__hip_atomic_fetch_add(ctr, 1u, __ATOMIC_RELAXED, __HIP_MEMORY_SCOPE_AGENT);
        unsigned spins = 0;
        while (__hip_atomic_load(ctr, __ATOMIC_RELAXED, __HIP_MEMORY_SCOPE_AGENT) < target) { __builtin_amdgcn_s_sleep(2); if (++spins > (1u << 23)) break; }
        __builtin_amdgcn_fence(__ATOMIC_ACQUIRE, "agent");
        asm volatile("s_waitcnt vmcnt(0)" ::: "memory");
    }
    __syncthreads();
}

#define XB_TMO      128
#define XB_XCNT(j)  (256  + 64 * (j))
#define XB_XSUB(j)  (1280 + 64 * (j))
#define XB_XGEN(j)  (2304 + 64 * (j))
#define XB_TOP      3328
#define XB_TOPGEN   3392
#define XCD_BAR_WORDS 3456
#define XB_SPIN_CAP (1u << 18)
__device__ __forceinline__ unsigned xb_ld(unsigned* p)              { return __hip_atomic_load(p, __ATOMIC_RELAXED, __HIP_MEMORY_SCOPE_AGENT); }
__device__ __forceinline__ unsigned xb_add(unsigned* p, unsigned v) { return __hip_atomic_fetch_add(p, v, __ATOMIC_RELAXED, __HIP_MEMORY_SCOPE_AGENT); }
__device__ __forceinline__ unsigned xb_xcc_id() { return (unsigned)__builtin_amdgcn_s_getreg((3 << 11) | 20) & 0xFu; }
#define XB_SPIN(cond, bar) do { unsigned _sp = 0; while (cond) { __builtin_amdgcn_s_sleep(1); \
    if ((++_sp & 255u) == 0u) { if (xb_ld(&(bar)[XB_TMO])) break; if (_sp > XB_SPIN_CAP) { atomicAdd(&(bar)[XB_TMO], 1u); break; } } } } while (0)
struct XcdBarrier { unsigned* bar; unsigned x; volatile LAS unsigned* st; };
__device__ __forceinline__ XcdBarrier xcd_barrier_post(unsigned* bar, volatile LAS unsigned* st) {
    XcdBarrier b; b.bar = bar; b.x = xb_xcc_id(); b.st = st;
    if (threadIdx.x == 0) (void)xb_add(&bar[XB_XCNT(b.x)], 1u);
    return b;
}
__device__ __forceinline__ void xcd_barrier_complete(unsigned* bar, unsigned x, unsigned& nloc, unsigned& nx) {
    const unsigned G = gridDim.x * gridDim.y * gridDim.z;
    unsigned sum, cnt, mine, sp = 0u;
    for (;;) {
        sum = 0u; cnt = 0u; mine = 0u;
#pragma unroll
        for (unsigned j = 0; j < 16; ++j) { const unsigned c = xb_ld(&bar[XB_XCNT(j)]); sum += c; cnt += (c > 0u) ? 1u : 0u; mine = (j == x) ? c : mine; }
        if (sum == G) break;
        __builtin_amdgcn_s_sleep(1);
        if ((++sp & 255u) == 0u) { if (xb_ld(&bar[XB_TMO])) break; if (sp > XB_SPIN_CAP) { atomicAdd(&bar[XB_TMO], 1u); break; } }
    }
    nloc = mine > 0u ? mine : 1u; nx = cnt > 0u ? cnt : 1u;
}
__device__ __forceinline__ void xcd_barrier(const XcdBarrier& b) {
    asm volatile("s_waitcnt vmcnt(0)" ::: "memory");
    __syncthreads();
    if (threadIdx.x == 0) {
        unsigned* bar = b.bar;
        __builtin_amdgcn_s_waitcnt(0);
        unsigned nloc = b.st[0], nx = b.st[1];
        if (nloc == 0u) { xcd_barrier_complete(bar, b.x, nloc, nx); b.st[0] = nloc; b.st[1] = nx; }
        const unsigned old = xb_add(&bar[XB_XSUB(b.x)], 1u);
        const unsigned gen = old / nloc;
        if (old + 1u == (gen + 1u) * nloc) {
            __builtin_amdgcn_fence(__ATOMIC_RELEASE, "agent");
            asm volatile("s_waitcnt vmcnt(0)" ::: "memory");
            const unsigned og = xb_add(&bar[XB_TOP], 1u);
            const unsigned tg = og / nx;
            if (og + 1u == (tg + 1u) * nx) xb_add(&bar[XB_TOPGEN], 1u);
            else XB_SPIN(xb_ld(&bar[XB_TOPGEN]) == tg, bar);
            __builtin_amdgcn_fence(__ATOMIC_ACQUIRE, "agent");
            xb_add(&bar[XB_XGEN(b.x)], 1u);
            asm volatile("s_waitcnt vmcnt(0)" ::: "memory");
        } else {
            XB_SPIN(xb_ld(&bar[XB_XGEN(b.x)]) == gen, bar);
            __builtin_amdgcn_fence(__ATOMIC_ACQUIRE, "agent");
            asm volatile("s_waitcnt vmcnt(0)" ::: "memory");
        }
    }
    __syncthreads();
}

__global__ void __launch_bounds__(NTHREADS, 2) fwd_kernel(Args a) {
    extern __shared__ __attribute__((aligned(16))) unsigned char lds[];
    LAS unsigned char* ldsl = (LAS unsigned char*)lds;
    const int G = gridDim.x, bx = blockIdx.x;
#define PHASE_IDS() int tid = threadIdx.x; asm volatile("" : "+v"(tid)); const int lane = tid & 63, wave = __builtin_amdgcn_readfirstlane(tid >> 6); (void)lane; (void)wave
    const int vcu = (G % 8 == 0) ? (bx % 8) * (G / 8) + bx / 8 : bx;
    unsigned char* ws = a.ws;
    float* MODP = (float*)(ws + WS_MODP); float* MOD = (float*)(ws + WS_MOD);
    bf16_t* WinT = (bf16_t*)(ws + WS_WIN); bf16_t* WdT = (bf16_t*)(ws + WS_WD); bf16_t* WbrAT = (bf16_t*)(ws + WS_WBRA); bf16_t* WbrBT = (bf16_t*)(ws + WS_WBRB);
    bf16_t* WoutT = (bf16_t*)(ws + WS_WOUT); bf16_t* WguT = (bf16_t*)(ws + WS_WGU);
    bf16_t* Hb = (bf16_t*)(ws + WS_H); bf16_t* KV = (bf16_t*)(ws + WS_KV); bf16_t* QG = (bf16_t*)(ws + WS_QG);
    bf16_t* OBraw = Hb; bf16_t* Tm = KV; bf16_t* HM = QG; bf16_t* H2 = Hb;
    const int lo = a.ph_lo, hi = a.ph_hi;
#ifndef PHMASK
#define PHMASK 0xFFFF
#endif
#define IN(k) (((PHMASK >> (k)) & 1) && lo <= (k) && (k) < hi)
    if (a.ph_hi > 4096) cg::this_grid().sync();
    volatile LAS unsigned* xb_st = (volatile LAS unsigned*)(ldsl + 139264);
    if (threadIdx.x < 4) xb_st[threadIdx.x] = 0u;
    __syncthreads();
    const XcdBarrier xbar = xcd_barrier_post((unsigned*)(ws + WS_BAR), xb_st);
#define SEAM(k) do { if (IN(k) && IN((k) + 1)) { xcd_barrier(xbar); } } while (0)

    if (IN(0)) for (int rep = 0; rep < NREP(0); ++rep) { if (rep) cg::this_grid().sync(); PHASE_IDS();
        LAS float* sc = (LAS float*)ldsl;
        LAS float* red = (LAS float*)(ldsl + 8192);
        const float* wada = a.in[I_WADA];
        typedef float f32x2_ __attribute__((ext_vector_type(2)));
        for (int it = bx; it < 96 * 8; it += G) {
            const int cc = it % 96, kc = it / 96;
            for (int idx = tid; idx < 1280; idx += NTHREADS) { const int cond = idx >> 8, kk = idx & 255;
                const float v = (cond < 4) ? a.in[I_C][cond * DM + kc * 256 + kk] : a.in[I_CCTX][kc * 256 + kk];
                sc[idx] = v / (1.0f + __expf(-v)); }
            __syncthreads();
            f32x2_ acc[5];
#pragma unroll
            for (int c5 = 0; c5 < 5; ++c5) acc[c5] = (f32x2_){0.f, 0.f};
            const float* wp = wada + (size_t)(kc * 256 + wave * 32) * ADAW + cc * 128 + lane * 2;
#pragma unroll 16
            for (int r = 0; r < 32; ++r) { const f32x2_ w2 = *(const f32x2_*)(wp + (size_t)r * ADAW);
#pragma unroll
                for (int c5 = 0; c5 < 5; ++c5) acc[c5] += sc[c5 * 256 + wave * 32 + r] * w2; }
#pragma unroll
            for (int c5 = 0; c5 < 5; ++c5) *(LAS f32x2_*)(red + (wave * 5 + c5) * 128 + lane * 2) = acc[c5];
            __syncthreads();
            for (int idx = tid; idx < 640; idx += NTHREADS) { const int cond = idx >> 7, col = idx & 127; float s = 0.f;
#pragma unroll
                for (int w = 0; w < 8; ++w) s += red[(w * 5 + cond) * 128 + col];
                MODP[(size_t)(kc * 5 + cond) * ADAW + cc * 128 + col] = s; }
            __syncthreads();
        }
        LAS float* scr = (LAS float*)(ldsl + wave * 16384);
        const int gw = vcu * NWAVES + wave, NGW = G * NWAVES;
        constexpr int I_1 = 32 * 320, I_2 = 32 * 64, I_3 = 16 * 64, I_4 = 32 * 64, I_5 = 32 * 176, I_6 = 32 * 176;
        constexpr int NITEMS = I_1 + I_2 + I_3 + I_4 + I_5 + I_6;
        for (int it = gw; it < NITEMS; it += NGW) {
            int r = it;
            if (r < I_1) { transpose_item(a.in[I_WIN], DM, INW, WinT, 3, scr, r, lane); continue; } r -= I_1;
            if (r < I_2) { transpose_item(a.in[I_WBRA], 2048, DM, WbrAT, 0, scr, r, lane); continue; } r -= I_2;
            if (r < I_3) { transpose_item(a.in[I_WBRB], 1024, DM, WbrBT, 0, scr, r, lane); continue; } r -= I_3;
            if (r < I_4) { transpose_item(a.in[I_WOUT], DM, DM, WoutT, 0, scr, r, lane); continue; } r -= I_4;
            if (r < I_5) { transpose_item(a.in[I_WFG], DM, DFF, WguT, 1, scr, r, lane); continue; } r -= I_5;
            transpose_item(a.in[I_WFU], DM, DFF, WguT, 2, scr, r, lane);
        }
        __syncthreads();
    }
    SEAM(0);

    if (IN(1)) for (int rep = 0; rep < NREP(1); ++rep) { if (rep) cg::this_grid().sync(); PHASE_IDS();
        LAS float* mA = (LAS float*)ldsl; LAS float* mS = mA + DM;
        const float* bada = a.in[I_BADA]; const float* g1 = a.in[I_N1G];
        for (int q = bx; q < 512; q += G) {
            const int cond = q < 256 ? (q >> 6) : 4;
            __syncthreads();
            for (int col = tid; col < DM; col += NTHREADS) { float sh = bada[col], scl = bada[DM + col];
#pragma unroll
                for (int kc = 0; kc < 8; ++kc) { sh += MODP[(size_t)(kc * 5 + cond) * ADAW + col]; scl += MODP[(size_t)(kc * 5 + cond) * ADAW + DM + col]; }
                mA[col] = g1[col] * (1.0f + scl); mS[col] = sh; }
            __syncthreads();
            if (q < 256) norm_chunk(a.in[I_X], Hb, q * 64, mA, mS, wave, lane);
            else if (wave < 4) norm_chunk(a.in[I_CTX], Hb + (size_t)MLAT * DM, (q - 256) * 4, mA, mS, wave, lane, 1);
        }
        for (int idx = bx * NTHREADS + tid; idx < 5 * ADAW; idx += G * NTHREADS) { const int cond = idx / ADAW, j = idx % ADAW; float v = bada[j];
#pragma unroll
            for (int kc = 0; kc < 8; ++kc) v += MODP[(size_t)(kc * 5 + cond) * ADAW + j];
            MOD[idx] = v; }
        __syncthreads();
    }
    SEAM(1);

    if (IN(2)) for (int rep = 0; rep < NREP(2); ++rep) { if (rep) cg::this_grid().sync(); PHASE_IDS();
        pg8::Gemm g{Hb, WinT, DM, DM, DM}; pg8::InprojOrder S; S.init(G, bx);
        pg8::EpiInproj E{KV, QG, a.in[I_KNA], a.in[I_KNB], a.in[I_QNA], a.in[I_QNB], (LAS float*)(ldsl + pg8::STAGE_BYTES)};
        pg8::gemm_phase<pg8::EpiInproj, pg8::InprojOrder>(ldsl, g, S, E);
    }
    SEAM(2);


    if (IN(4)) for (int rep = 0; rep < NREP(4); ++rep) { if (rep) cg::this_grid().sync(); PHASE_IDS();
        bool fastA;
        { float gmq = fmaxf(fabsf(a.in[I_QNA][lane]), fabsf(a.in[I_QNA][lane + 64])), gmk = fmaxf(fabsf(a.in[I_KNA][lane]), fabsf(a.in[I_KNA][lane + 64]));
#pragma unroll
          for (int o = 1; o < 64; o <<= 1) { gmq = fmaxf(gmq, __shfl_xor(gmq, o)); gmk = fmaxf(gmk, __shfl_xor(gmk, o)); }
          fastA = __uint_as_float(__builtin_amdgcn_readfirstlane(__float_as_uint((11.313708499f * 1.4426950408889634f * 1.02f) * gmq * gmk))) <= 60.f; }
#define ATT_A_LOOP(FASTV) for (int L = vcu; L < 1024; L += G) { \
            const int grp = L >> 6, rem = L & 63, b = grp >> 2, kvh = grp & 3, h = kvh * 4 + (rem >> 4), qb = rem & 15; \
            bf16_t* Qb = QG + (size_t)(b * SEQ + qb * 256) * QGW + h * 128; \
            const bf16_t* Kh = KV + (size_t)b * SKV * KVW + kvh * 128; const bf16_t* Vh = Kh + 512; \
            bf16_t* Ob = (NREP(4) == 2 && rep == 0) ? (bf16_t*)(ws + WS_WIN + 24 * MiB) : Qb; \
            if (FASTV) att::attn_unit_fast<128, QGW, QGW>(Qb, Kh, Vh, Ob, (char*)lds); else att::attn_unit<128, QGW, QGW, false, 1>(Qb, Kh, Vh, Ob, (char*)lds); }
#define ATT_B_FALLBACK() for (int L2 = vcu; L2 < 1024; L2 += G) { \
            const int grp = L2 >> 5, rem = L2 & 31, b = grp >> 3, h = grp & 7, sub = rem >> 4, qb = rem & 15; \
            const bf16_t* Qb = QG + (size_t)(b * SEQ + qb * 256) * QGW + 2048 + (h * 2 + sub) * 64; \
            const bf16_t* Kh = KV + (size_t)b * SKV * KVW + 1024 + (h * 2 + sub) * 64; const bf16_t* Vh = KV + (size_t)b * SKV * KVW + 2048 + h * 128; \
            bf16_t* Ob = OBraw + (size_t)(b * SEQ + qb * 256) * DM + (h * 2 + sub) * 128; \
            att::attn_unit<64, QGW, DM, false, 1>(Qb, Kh, Vh, Ob, (char*)lds); }
#define ATT_B_PAIRS() for (int L2 = vcu; L2 < 512; L2 += G) { \
            const int grp = L2 >> 4, b = grp >> 3, h = grp & 7, qb = L2 & 15; \
            const bf16_t* Qb = QG + (size_t)(b * SEQ + qb * 256) * QGW + 2048 + h * 128; \
            const bf16_t* Kh = KV + (size_t)b * SKV * KVW + 1024 + h * 128; const bf16_t* Vh = KV + (size_t)b * SKV * KVW + 2048 + h * 128; \
            att::attn_unit_fast<64, QGW, QGW>(Qb, Kh, Vh, nullptr, (char*)lds, 1); \
            att::attn_unit_fast<64, QGW, QGW>(Qb + 64, Kh + 64, Vh, QG + (size_t)(b * SEQ + qb * 256) * QGW + 2048 + h * 128, (char*)lds, 2, lam, a.in[I_SUBLN]); }
#define ATT_FENCE() do { asm volatile("" ::: "memory"); __builtin_amdgcn_sched_barrier(0); } while (0)
#ifndef ATT_X
#define ATT_X 15
#endif
        if (fastA) { if (ATT_X & 1) ATT_A_LOOP(true) } else { if (ATT_X & 2) ATT_A_LOOP(false) }
        ATT_FENCE();
        float lam; bool fastB;
        { int ln = threadIdx.x & 63; asm volatile("" : "+v"(ln));
          float g1_ = fabsf(a.in[I_QNB][ln]), g2_ = fabsf(a.in[I_KNB][ln]);
          float s1_ = a.in[I_LQ1][ln] * a.in[I_LK1][ln], s2_ = a.in[I_LQ2][ln] * a.in[I_LK2][ln];
#pragma unroll
          for (int o = 1; o < 64; o <<= 1) { g1_ = fmaxf(g1_, __shfl_xor(g1_, o)); g2_ = fmaxf(g2_, __shfl_xor(g2_, o)); s1_ += __shfl_xor(s1_, o); s2_ += __shfl_xor(s2_, o); }
          fastB = __uint_as_float(__builtin_amdgcn_readfirstlane(__float_as_uint((8.0f * 1.4426950408889634f * 1.02f) * g1_ * g2_))) <= 60.f;
          lam = __uint_as_float(__builtin_amdgcn_readfirstlane(__float_as_uint(expf(s1_) - expf(s2_) + 0.2f))); }
        if (fastB) { if (ATT_X & 4) ATT_B_PAIRS() } else { if (ATT_X & 8) ATT_B_FALLBACK() }
    }
    SEAM(4);
    bool p5_needed;
    { const int ln = threadIdx.x & 63; float g1_ = fabsf(a.in[I_QNB][ln]), g2_ = fabsf(a.in[I_KNB][ln]);
#pragma unroll
      for (int o = 1; o < 64; o <<= 1) { g1_ = fmaxf(g1_, __shfl_xor(g1_, o)); g2_ = fmaxf(g2_, __shfl_xor(g2_, o)); }
      p5_needed = !(__uint_as_float(__builtin_amdgcn_readfirstlane(__float_as_uint((8.0f * 1.4426950408889634f * 1.02f) * g1_ * g2_))) <= 60.f); }

    if (IN(5) && p5_needed) for (int rep = 0; rep < NREP(5); ++rep) { if (rep) cg::this_grid().sync(); PHASE_IDS();
        const int gw = vcu * NWAVES + wave, NGW = G * NWAVES;
        const float s1 = wave_sum(a.in[I_LQ1][lane] * a.in[I_LK1][lane]), s2 = wave_sum(a.in[I_LQ2][lane] * a.in[I_LK2][lane]);
        const float lam_init = 0.2f, lam = expf(s1) - expf(s2) + lam_init;
        const int h = lane >> 3, e0 = (lane & 7) * 16; const float* sg = a.in[I_SUBLN];
        float gg[16];
#pragma unroll
        for (int e = 0; e < 16; ++e) gg[e] = sg[e0 + e] * (1.0f - lam_init);
        for (int t = gw; t < MLAT; t += NGW) {
            const bf16_t* src = OBraw + (size_t)t * DM + (h * 2) * 128 + e0;
            const u32x4 a0 = *(const u32x4*)src, a1 = *(const u32x4*)(src + 8), b0 = *(const u32x4*)(src + 128), b1 = *(const u32x4*)(src + 136);
            float x0[16], x1[16]; unpack8(a0, x0); unpack8(a1, x0 + 8); unpack8(b0, x1); unpack8(b1, x1 + 8);
            float d[16]; float ss = 0.f;
#pragma unroll
            for (int e = 0; e < 16; ++e) { d[e] = x0[e] - lam * x1[e]; ss += d[e] * d[e]; }
            ss += __shfl_xor(ss, 1); ss += __shfl_xor(ss, 2); ss += __shfl_xor(ss, 4);
            const float rstd = rsqrtf(ss * (1.0f / 128) + EPS);
#pragma unroll
            for (int e = 0; e < 16; ++e) d[e] = d[e] * rstd * gg[e];
            bf16_t* dst = QG + (size_t)t * QGW + 2048 + h * 128 + e0;
            *(u32x4*)dst = pack8(d); *(u32x4*)(dst + 8) = pack8(d + 8);
        }
    }
    if (p5_needed) SEAM(5);

    if (IN(6)) for (int rep = 0; rep < NREP(6); ++rep) { if (rep) cg::this_grid().sync(); PHASE_IDS();
        {
            const int gw = vcu * NWAVES + wave, NGW = G * NWAVES; LAS float* scr = (LAS float*)(ldsl + wave * 16384);
            for (int it = gw; it < 88 * 64; it += NGW) transpose_item(a.in[I_WFD], DFF, DM, WdT, 0, scr, it, lane);
            __syncthreads(); }
        { pg8::Gemm g{QG, WbrAT, 2048, QGW, 2048}; pg8::StaticOrder S; S.init(MLAT, DM, G, bx);
          pg8::EpiBranch<0> E{Tm, QG, 3072};
          pg8::gemm_phase<pg8::EpiBranch<0>, pg8::StaticOrder>(ldsl, g, S, E); }
        { pg8::Gemm g{QG + 2048, WbrBT, 1024, QGW, 1024}; pg8::StaticOrder S; S.init(MLAT, DM, G, bx);
          pg8::EpiBranch<1> E{Tm, QG, 5120};
          pg8::gemm_phase<pg8::EpiBranch<1>, pg8::StaticOrder>(ldsl, g, S, E); }
    }
    SEAM(6);

    if (IN(7)) for (int rep = 0; rep < NREP(7); ++rep) { if (rep) cg::this_grid().sync(); PHASE_IDS();
        pg8::Gemm g{Tm, WoutT, DM, DM, DM}; pg8::StaticOrder S; S.init(MLAT, DM, G, bx);
        pg8::EpiResid E{a.in[I_X], a.out, MOD + 2 * DM};
        pg8::gemm_phase<pg8::EpiResid, pg8::StaticOrder>(ldsl, g, S, E);
    }
    SEAM(7);

    if (IN(8)) for (int rep = 0; rep < NREP(8); ++rep) { if (rep) cg::this_grid().sync(); PHASE_IDS();
        LAS float* mA = (LAS float*)ldsl; LAS float* mS = mA + DM; const float* g2 = a.in[I_N2G];
        for (int q = bx; q < 256; q += G) {
            const int cond = q >> 6;
            __syncthreads();
            for (int col = tid; col < DM; col += NTHREADS) { mA[col] = g2[col] * (1.0f + MOD[(size_t)cond * ADAW + 4 * DM + col]); mS[col] = MOD[(size_t)cond * ADAW + 3 * DM + col]; }
            __syncthreads();
            norm_chunk(a.out, H2, q * 64, mA, mS, wave, lane);
        }
        __syncthreads();
    }
    SEAM(8);

    if (IN(9)) for (int rep = 0; rep < NREP(9); ++rep) { if (rep) cg::this_grid().sync(); PHASE_IDS();
        pg8::Gemm g{H2, WguT, DM, DM, DM}; pg8::StaticOrder S; S.init(MLAT, 2 * DFF, G, bx);
        pg8::EpiSwiglu E{HM};
        pg8::gemm_phase<pg8::EpiSwiglu, pg8::StaticOrder, false>(ldsl, g, S, E);
    }
    SEAM(9);

    if (IN(10)) for (int rep = 0; rep < NREP(10); ++rep) { if (rep) cg::this_grid().sync(); PHASE_IDS();
        pg8::Gemm g{HM, WdT, DFF, DFF, DFF}; pg8::StaticOrder S; S.init(MLAT, DM, G, bx);
        pg8::EpiResid E{a.out, a.out, MOD + 5 * DM};
        pg8::gemm_phase<pg8::EpiResid, pg8::StaticOrder>(ldsl, g, S, E);
    }
    if (REPMASK & 2048) { for (int i = 0; i < 10; ++i) cg::this_grid().sync(); }
#undef IN
#undef SEAM
}

extern "C" void kernel_launch(void* const* d_in, const int* in_sizes, int n_in, void* d_out, int out_size, void* d_ws, size_t ws_size, hipStream_t stream) {
    static int grid = 0;
    if (grid == 0) {
        if (n_in != 24 || in_sizes[0] != MLAT * DM || out_size != MLAT * DM || ws_size < WS_END) {
            fprintf(stderr, "kernel_launch: unexpected shapes (n_in %d, in0 %d, out %d, ws %zu)\n", n_in, n_in > 0 ? in_sizes[0] : -1, out_size, ws_size); grid = -1; return; }
        int dev = 0, cus = 0, per_cu = 0;
        if (hipGetDevice(&dev) != hipSuccess || hipDeviceGetAttribute(&cus, hipDeviceAttributeMultiprocessorCount, dev) != hipSuccess) { grid = -1; return; }
        if (hipFuncSetAttribute((const void*)fwd_kernel, hipFuncAttributeMaxDynamicSharedMemorySize, LDS_BYTES) != hipSuccess) { fprintf(stderr, "kernel_launch: hipFuncSetAttribute failed\n"); grid = -1; return; }
        if (hipOccupancyMaxActiveBlocksPerMultiprocessor(&per_cu, (const void*)fwd_kernel, NTHREADS, LDS_BYTES) != hipSuccess || per_cu < 1) { fprintf(stderr, "kernel_launch: occupancy query failed (%d)\n", per_cu); per_cu = 1; }
        (void)hipGetLastError();
        grid = cus * per_cu;
        if (grid > 256) grid = 256;
    }
    if (grid < 0) return;
    Args a{};
    for (int i = 0; i < 24; ++i) a.in[i] = (const float*)d_in[i];
    a.out = (float*)d_out; a.ws = (unsigned char*)d_ws;
#if MK_SINGLE
    (void)hipMemsetAsync((char*)d_ws + WS_BAR, 0, XCD_BAR_WORDS * 4, stream);
    a.ph_lo = 0; a.ph_hi = NPHASES;
    void* args[] = {&a};
    hipError_t e = hipLaunchCooperativeKernel((void*)fwd_kernel, dim3(grid), dim3(NTHREADS), args, LDS_BYTES, stream);
    if (e != hipSuccess) fprintf(stderr, "cooperative launch failed: %s (grid %d)\n", hipGetErrorString(e), grid);
#else
    for (int p = 0; p < NPHASES; ++p) {
        a.ph_lo = p; a.ph_hi = p + 1;
        hipLaunchKernelGGL(fwd_kernel, dim3(grid), dim3(NTHREADS), LDS_BYTES, stream, a);
    }
#endif
}
```

```cpp
#include <hip/hip_runtime.h>
#include <hip/hip_bf16.h>
#include <hip/hip_cooperative_groups.h>
#include <cstdio>
#include <cstdint>
namespace cg = cooperative_groups;

#ifndef MK_SINGLE
#define MK_SINGLE 1
#endif

#ifndef REPMASK
#define REPMASK 0
#endif
#define NREP(k) (1 + ((REPMASK >> (k)) & 1))
#define LAS __attribute__((address_space(3)))
typedef unsigned short bf16_t;
typedef short bf16x8 __attribute__((ext_vector_type(8)));
typedef short s16x4 __attribute__((ext_vector_type(4)));
typedef float f32x4 __attribute__((ext_vector_type(4)));
typedef float f32x16 __attribute__((ext_vector_type(16)));
typedef unsigned u32x4 __attribute__((ext_vector_type(4)));
typedef unsigned u32x2 __attribute__((ext_vector_type(2)));

constexpr int DM = 2048, NBATCH = 4, SEQ = 4096, CTXL = 256, SKV = SEQ + CTXL;
constexpr int MLAT = NBATCH * SEQ, MCTX = NBATCH * CTXL, MALL = MLAT + MCTX;
constexpr int KVW = 3072, INW = 10240, QGW = 7168, DFF = 5632, ADAW = 12288;
constexpr float EPS = 1e-6f;
constexpr float QSC_A = 0.088388347648318440f * 1.4426950408889634f, QSC_B = 0.125f * 1.4426950408889634f;
constexpr int NTHREADS = 512, NWAVES = 8;
constexpr int LDS_BYTES = 143360;

constexpr size_t MiB = 1u << 20;
constexpr size_t WS_MODP = 0;
constexpr size_t WS_MOD = 2 * MiB;
constexpr size_t WS_BAR = 3 * MiB;
constexpr size_t WS_WIN = 4 * MiB;
constexpr size_t WS_WD = 4 * MiB;
constexpr size_t WS_WBRA = 44 * MiB;
constexpr size_t WS_WBRB = 52 * MiB;
constexpr size_t WS_WOUT = 56 * MiB;
constexpr size_t WS_WGU = 64 * MiB;
constexpr size_t WS_H = 108 * MiB;
constexpr size_t WS_KV = 176 * MiB;
constexpr size_t WS_QG = 278 * MiB;
constexpr size_t WS_END = 502 * MiB;

__device__ __forceinline__ unsigned cvt_pk_bf16(float lo, float hi) { unsigned r; asm volatile("v_cvt_pk_bf16_f32 %0, %1, %2" : "=v"(r) : "v"(lo), "v"(hi)); return r; }
__device__ __forceinline__ float bf_lo(unsigned w) { return __uint_as_float(w << 16); }
__device__ __forceinline__ float bf_hi(unsigned w) { return __uint_as_float(w & 0xffff0000u); }
__device__ __forceinline__ float wave_sum(float v) {
#pragma unroll
    for (int o = 1; o < 64; o <<= 1) v += __shfl_xor(v, o);
    return v;
}
__device__ __forceinline__ float sigmoidf_(float x) { return __builtin_amdgcn_rcpf(1.0f + __builtin_amdgcn_exp2f(-1.4426950408889634f * x)); }
__device__ __forceinline__ void unpack8(u32x4 w, float* x) {
    x[0] = bf_lo(w.x); x[1] = bf_hi(w.x); x[2] = bf_lo(w.y); x[3] = bf_hi(w.y); x[4] = bf_lo(w.z); x[5] = bf_hi(w.z); x[6] = bf_lo(w.w); x[7] = bf_hi(w.w);
}
__device__ __forceinline__ u32x4 pack8(const float* x) {
    u32x4 w; w.x = cvt_pk_bf16(x[0], x[1]); w.y = cvt_pk_bf16(x[2], x[3]); w.z = cvt_pk_bf16(x[4], x[5]); w.w = cvt_pk_bf16(x[6], x[7]); return w;
}

namespace pg8 {
constexpr int BM = 256, BK = 64, HALF = 128, HTB = HALF * BK * 2, STAGE_BYTES = 8 * HTB, NXCD = 8, WGM = 8;
__host__ __device__ __forceinline__ int lds_byte(int r, int c) { const int st = (r >> 4) * 2 + (c >> 5), rr = r & 15, cc = c & 31, ob = rr * 64 + cc * 2; return st * 1024 + (ob ^ (((ob >> 9) & 1) << 5)); }
__host__ __device__ __forceinline__ void stage_rc(int b, int& R, int& C) { const int st = b / 1024, sb = b % 1024, swz = sb ^ (((sb >> 9) & 1) << 5); R = (st >> 1) * 16 + swz / 64; C = (st & 1) * 32 + (swz % 64) / 2; }
__host__ __device__ __forceinline__ int perm32(int rho) { const int n = rho >> 4, i = rho & 15; return 8 * (i >> 2) + 4 * n + (i & 3); }

struct Unit { int pm, pn; };
struct Gemm { const bf16_t* A; const bf16_t* Bt; int K, lda, ldb; };

struct StaticOrder {
    int nM, nN, nwg, G, c;
    __device__ void init(int M, int N, int G_, int c_) { nM = M / BM; nN = N / BM; nwg = nM * nN; G = G_; c = c_; }
    __device__ bool map(long L, Unit& u) const {
        if (L >= nwg) return false;
        int wgid = (int)L; { const int q = nwg / NXCD, r = nwg % NXCD, xcd = wgid % NXCD, off = wgid / NXCD; wgid = (xcd < r ? xcd * (q + 1) : r * (q + 1) + (xcd - r) * q) + off; }
        const int nig = WGM * nN, gid = wgid / nig, fm = gid * WGM, gsz = (nM - fm) < WGM ? (nM - fm) : WGM;
        u.pm = fm + ((wgid % nig) % gsz); u.pn = (wgid % nig) / gsz; return true;
    }
    __device__ bool next(int i, Unit& u) const { return map((long)i * G + c, u); }
};
struct InprojOrder {
    StaticOrder so;
    __device__ void init(int G_, int c_) { so.init(MLAT, INW, G_, c_); }
    __device__ bool next(int i, Unit& u) const {
        const long L = (long)i * so.G + so.c;
        if (L < so.nwg) return so.map(L, u);
        const int L2 = (int)(L - so.nwg); if (L2 >= 48) return false;
        u.pm = 64 + L2 / 12; u.pn = L2 % 12; return true;
    }
};

template <class Epi, class Sched>
__device__ __forceinline__ void gemm_phase(LAS unsigned char* lds, const Gemm g, const Sched& S, const Epi& E) {
    const int tid = threadIdx.x, wid = __builtin_amdgcn_readfirstlane(tid >> 6), lane = tid & 63, wr = wid >> 2, wc = wid & 3, fr = lane & 15, fq = lane >> 4;
    const int nt = g.K / BK;
    unsigned voffA[2], voffB[2];
#pragma unroll
    for (int i = 0; i < 2; ++i) { int R, C; stage_rc(tid * 16 + i * 8192, R, C); const int Rb = (R & ~31) + perm32(R & 31);
        voffA[i] = (unsigned)(R * g.lda + C) * 2u; voffB[i] = (unsigned)(Rb * g.ldb + C) * 2u; }
    const size_t kstep = (size_t)(BK * 2);
    const size_t hA = (size_t)HALF * g.lda * 2, hB = (size_t)HALF * g.ldb * 2, tA = 2 * hA, tB = 2 * hB;
    const unsigned ldsw = (unsigned)wid * 1024u;
    const int aoff = lds_byte(wr * 64 + fr, fq * 8), boff = lds_byte(wc * 32 + fr, fq * 8);
#define PG8_SA(b, h) (((b) * 2 + (h)) * HTB)
#define PG8_SB(b, h) ((4 + (b) * 2 + (h)) * HTB)
#define PG8_STAGE(bufoff, gbase, voff) do { _Pragma("unroll") for (int _i = 0; _i < 2; ++_i) \
        __builtin_amdgcn_global_load_lds((const unsigned*)((const char*)(gbase) + (voff)[_i]), (LAS unsigned*)(lds + (bufoff) + ldsw + _i * 8192), 16, 0, 0); } while (0)
#define PG8_LDA(dst, b, h) do { _Pragma("unroll") for (int m = 0; m < 4; ++m) _Pragma("unroll") for (int k = 0; k < 2; ++k) dst[m][k] = *(const LAS bf16x8*)(lds + PG8_SA(b, h) + aoff + m * 2048 + k * 1024); } while (0)
#define PG8_LDB(dst, b, h) do { _Pragma("unroll") for (int n = 0; n < 2; ++n) _Pragma("unroll") for (int k = 0; k < 2; ++k) dst[n][k] = *(const LAS bf16x8*)(lds + PG8_SB(b, h) + boff + n * 2048 + k * 1024); } while (0)
#define PG8_MMA(ai, bj, At, Bt) do { __builtin_amdgcn_s_setprio(1); _Pragma("unroll") for (int m = 0; m < 4; ++m) _Pragma("unroll") for (int n = 0; n < 2; ++n) _Pragma("unroll") for (int k = 0; k < 2; ++k) \
        acc[ai][bj][m][n] = __builtin_amdgcn_mfma_f32_16x16x32_bf16(Bt[n][k], At[m][k], acc[ai][bj][m][n], 0, 0, 0); __builtin_amdgcn_s_setprio(0); } while (0)
#define PG8_WAIT_V(n) asm volatile("s_waitcnt vmcnt(" #n ")" ::: "memory")
#define PG8_WAIT_L(n) asm volatile("s_waitcnt lgkmcnt(" #n ")" ::: "memory")
#define PG8_BAR __builtin_amdgcn_s_barrier()
#define PG8_SCHED __builtin_amdgcn_sched_barrier(0)
    Unit cur, nxt; int ui = 0;
    if (!S.next(0, cur)) return;
    f32x4 acc[2][2][4][2];
#pragma unroll
    for (int a = 0; a < 2; ++a)
#pragma unroll
        for (int b = 0; b < 2; ++b)
#pragma unroll
            for (int m = 0; m < 4; ++m)
#pragma unroll
                for (int n = 0; n < 2; ++n) acc[a][b][m][n] = (f32x4){0.f, 0.f, 0.f, 0.f};
    bf16x8 At[4][2], B0[2][2], B1[2][2];
    const char* cA = (const char*)g.A + (size_t)cur.pm * tA; const char* cB = (const char*)g.Bt + (size_t)cur.pn * tB;
    PG8_STAGE(PG8_SB(0, 0), cB, voffB); PG8_STAGE(PG8_SB(0, 1), cB + hB, voffB); PG8_STAGE(PG8_SA(0, 0), cA, voffA); PG8_STAGE(PG8_SA(0, 1), cA + hA, voffA);
    if (wr == 1) PG8_BAR;
    PG8_WAIT_V(2); PG8_BAR;
    PG8_STAGE(PG8_SB(1, 0), cB + kstep, voffB); PG8_STAGE(PG8_SA(1, 0), cA + kstep, voffA); PG8_STAGE(PG8_SB(1, 1), cB + hB + kstep, voffB);
    PG8_WAIT_V(6); PG8_BAR;
    for (;;) {
        const bool has_next = S.next(ui + 1, nxt);
        const char* nA = has_next ? (const char*)g.A + (size_t)nxt.pm * tA : cA; const char* nB = has_next ? (const char*)g.Bt + (size_t)nxt.pn * tB : cB;
        for (int t = 0; t < nt; t += 2) {
            const bool last = (t == nt - 2);
            const char* a1 = cA + (size_t)(t + 1) * kstep;
            const char* a2 = last ? nA : cA + (size_t)(t + 2) * kstep; const char* b2 = last ? nB : cB + (size_t)(t + 2) * kstep;
            const char* a3 = a2 + kstep; const char* b3 = b2 + kstep;
            PG8_LDB(B0, 0, 0); PG8_LDB(B1, 0, 1); PG8_SCHED; PG8_LDA(At, 0, 0); PG8_STAGE(PG8_SA(1, 1), a1 + hA, voffA);
            PG8_WAIT_V(8); PG8_WAIT_L(0); PG8_BAR; PG8_MMA(0, 0, At, B0); PG8_MMA(0, 1, At, B1); PG8_BAR; PG8_SCHED;
            PG8_LDA(At, 0, 1); PG8_STAGE(PG8_SB(0, 0), b2, voffB); PG8_STAGE(PG8_SB(0, 1), b2 + hB, voffB); PG8_STAGE(PG8_SA(0, 0), a2, voffA);
            PG8_WAIT_V(8); PG8_WAIT_L(0); PG8_BAR; PG8_MMA(1, 0, At, B0); PG8_MMA(1, 1, At, B1); PG8_BAR; PG8_SCHED;
            PG8_LDB(B0, 1, 0); PG8_LDB(B1, 1, 1); PG8_SCHED; PG8_LDA(At, 1, 0); PG8_STAGE(PG8_SA(0, 1), a2 + hA, voffA);
            PG8_WAIT_V(8); PG8_WAIT_L(0); PG8_BAR; PG8_MMA(0, 0, At, B0); PG8_MMA(0, 1, At, B1); PG8_BAR; PG8_SCHED;
            PG8_LDA(At, 1, 1); PG8_STAGE(PG8_SB(1, 0), b3, voffB); PG8_STAGE(PG8_SB(1, 1), b3 + hB, voffB); PG8_STAGE(PG8_SA(1, 0), a3, voffA);
            PG8_WAIT_V(8); PG8_WAIT_L(0); PG8_BAR; PG8_MMA(1, 0, At, B0); PG8_MMA(1, 1, At, B1); PG8_BAR; PG8_SCHED;
        }
        if (wr == 0) PG8_BAR;
        E(acc, cur, wr, wc, fr, fq);
        if (!has_next) break;
#pragma unroll
        for (int a = 0; a < 2; ++a)
#pragma unroll
            for (int b = 0; b < 2; ++b)
#pragma unroll
                for (int m = 0; m < 4; ++m)
#pragma unroll
                    for (int n = 0; n < 2; ++n) acc[a][b][m][n] = (f32x4){0.f, 0.f, 0.f, 0.f};
        cur = nxt; cA = nA; cB = nB; ++ui;
        if (wr == 1) PG8_BAR;
    }
    PG8_WAIT_V(0);
    PG8_BAR;
#undef PG8_SA
#undef PG8_SB
#undef PG8_STAGE
#undef PG8_LDA
#undef PG8_LDB
#undef PG8_MMA
#undef PG8_WAIT_V
#undef PG8_WAIT_L
#undef PG8_BAR
#undef PG8_SCHED
}

typedef f32x4 Acc[2][2][4][2];
#define EPI_FENCE() asm volatile("" ::: "memory")

struct EpiInproj {
    bf16_t* KV; bf16_t* QG; const float* gka; const float* gkb; const float* gqa; const float* gqb; LAS float* X;
    __device__ __forceinline__ void operator()(const Acc& acc, const Unit& u, int wr, int wc, int fr_, int fq_) const {
        int fr = fr_, fq = fq_; asm volatile("" : "+v"(fr), "+v"(fq));
        bf16_t* base; size_t ld; int rowbase, colt; bool sig = false; int hk = 0; const float* g = nullptr; float osc = 1.f;
        if (u.pn < 12) { base = KV; ld = KVW; colt = u.pn * BM;
            if (u.pm < 64) rowbase = (u.pm >> 4) * SKV + CTXL + (u.pm & 15) * BM; else rowbase = (u.pm - 64) * SKV;
            if (u.pn < 2) { hk = 1; g = gka; } else if (u.pn >= 4 && u.pn < 8) { hk = 2; g = gkb; } }
        else { base = QG; ld = QGW; colt = (u.pn - 12) * BM; rowbase = u.pm * BM; sig = u.pn >= 24;
            if (u.pn < 20) { hk = 1; g = gqa; osc = QSC_A; } else if (u.pn < 24) { hk = 2; g = gqb; osc = QSC_B; } }
        const int row0 = rowbase + wr * 64 + fr, col0 = colt + wc * 32 + 8 * fq;
        if (hk == 0) {
#pragma unroll
            for (int ai = 0; ai < 2; ++ai)
#pragma unroll
                for (int m = 0; m < 4; ++m) { bf16_t* rowp = base + (size_t)(row0 + ai * HALF + m * 16) * ld + col0;
#pragma unroll
                    for (int bj = 0; bj < 2; ++bj) { f32x4 v0 = acc[ai][bj][m][0], v1 = acc[ai][bj][m][1];
                        if (sig) {
#pragma unroll
                            for (int j = 0; j < 4; ++j) { v0[j] = sigmoidf_(v0[j]); v1[j] = sigmoidf_(v1[j]); } }
                        u32x4 w; w.x = cvt_pk_bf16(v0[0], v0[1]); w.y = cvt_pk_bf16(v0[2], v0[3]); w.z = cvt_pk_bf16(v1[0], v1[1]); w.w = cvt_pk_bf16(v1[2], v1[3]);
                        *(u32x4*)(rowp + bj * HALF) = w; } }
            return;
        }
#pragma unroll
        for (int ai = 0; ai < 2; ++ai)
#pragma unroll
            for (int m = 0; m < 4; ++m)
#pragma unroll
                for (int bj = 0; bj < 2; ++bj) { const f32x4 v0 = acc[ai][bj][m][0], v1 = acc[ai][bj][m][1];
                    float sq = (v0[0] * v0[0] + v0[1] * v0[1]) + (v0[2] * v0[2] + v0[3] * v0[3]) + (v1[0] * v1[0] + v1[1] * v1[1]) + (v1[2] * v1[2] + v1[3] * v1[3]);
                    sq += __shfl_xor(sq, 16); sq += __shfl_xor(sq, 32);
                    if (fq == 0) X[((ai * HALF + wr * 64 + m * 16 + fr) * 2 + bj) * 4 + wc] = sq; }
        asm volatile("s_waitcnt lgkmcnt(0)" ::: "memory"); __builtin_amdgcn_s_barrier(); asm volatile("" ::: "memory");
        const bool h128 = (hk == 1), rope = u.pm < 64;
        const int t0 = h128 ? (16 * wc + 4 * fq) : (16 * (wc & 1) + 4 * fq);
        const int hd2 = h128 ? 64 : 32, nf = h128 ? 32 : 16;
        const bool userow = t0 < nf; const float inv_w = h128 ? (1.0f / 128) : (1.0f / 64);
#pragma unroll
        for (int ai = 0; ai < 2; ++ai)
#pragma unroll
            for (int m = 0; m < 4; ++m) { const int rt = ai * HALF + wr * 64 + m * 16 + fr;
                const int sp = (u.pm & 15) * BM + rt; const float pos = userow ? (float)(sp >> 6) : (float)(sp & 63);
                float cs[4], sn[4], ga[4], gb[4];
                { const float* gp = g + t0; asm volatile("" : "+v"(gp));
                  const f32x4 g1 = *(const f32x4*)gp, g2 = *(const f32x4*)(gp + hd2);
#pragma unroll
                  for (int p = 0; p < 4; ++p) { ga[p] = g1[p] * osc; gb[p] = g2[p] * osc; } }
#pragma unroll
                for (int p = 0; p < 4; ++p) { const float ang = pos * __builtin_amdgcn_exp2f(-(float)((t0 + p) & (nf - 1)) * (13.287712379549449f / (float)nf));
                    cs[p] = rope ? __cosf(ang) : 1.f; sn[p] = rope ? __sinf(ang) : 0.f; }
                bf16_t* rowp = base + (size_t)(rowbase + rt) * ld + col0;
#pragma unroll
                for (int bj = 0; bj < 2; ++bj) { const f32x4 xs = *(const LAS f32x4*)(X + (rt * 2 + bj) * 4);
                    const float tot = h128 ? ((xs[0] + xs[1]) + (xs[2] + xs[3])) : ((wc & 2) ? (xs[2] + xs[3]) : (xs[0] + xs[1]));
                    const float rstd = rsqrtf(tot * inv_w + EPS);
                    const f32x4 v0 = acc[ai][bj][m][0], v1 = acc[ai][bj][m][1];
                    float o[8]; const float e[8] = {v0[0], v0[1], v0[2], v0[3], v1[0], v1[1], v1[2], v1[3]};
#pragma unroll
                    for (int p = 0; p < 4; ++p) { const float x1 = e[2 * p] * rstd * ga[p], x2 = e[2 * p + 1] * rstd * gb[p];
                        o[2 * p] = x1 * cs[p] - x2 * sn[p]; o[2 * p + 1] = x2 * cs[p] + x1 * sn[p]; }
                    *(u32x4*)(rowp + bj * HALF) = pack8(o); }
                EPI_FENCE(); __builtin_amdgcn_sched_barrier(0); }
    }
};
template <int MODE> struct EpiBranch {
    bf16_t* T; const bf16_t* QG; int gcol0;
    __device__ __forceinline__ void operator()(const Acc& acc, const Unit& u, int wr, int wc, int fr, int fq) const {
        const int row0 = u.pm * BM + wr * 64 + fr, col0 = u.pn * BM + wc * 32 + 8 * fq;
#pragma unroll
        for (int ai = 0; ai < 2; ++ai)
#pragma unroll
            for (int m = 0; m < 4; ++m) { const int row = row0 + ai * HALF + m * 16;
#pragma unroll
                for (int bj = 0; bj < 2; ++bj) {
                    const u32x4 gw = *(const u32x4*)(QG + (size_t)row * QGW + gcol0 + col0 + bj * HALF);
                    float gt[8]; unpack8(gw, gt);
                    bf16_t* tp = T + (size_t)row * DM + col0 + bj * HALF;
                    float o[8];
                    const f32x4 v0 = acc[ai][bj][m][0], v1 = acc[ai][bj][m][1];
#pragma unroll
                    for (int j = 0; j < 4; ++j) { o[j] = gt[j] * v0[j]; o[4 + j] = gt[4 + j] * v1[j]; }
                    if (MODE == 1) { const u32x4 tw = *(const u32x4*)tp; float tv[8]; unpack8(tw, tv);
#pragma unroll
                        for (int j = 0; j < 8; ++j) o[j] += tv[j]; }
                    *(u32x4*)tp = pack8(o); }
                EPI_FENCE(); }
    }
};
struct EpiResid {
    const float* base; float* out; const float* gate;
    __device__ __forceinline__ void operator()(const Acc& acc, const Unit& u, int wr, int wc, int fr, int fq) const {
        const int row0 = u.pm * BM + wr * 64 + fr, col0 = u.pn * BM + wc * 32 + 8 * fq;
        const float* gp = gate + (size_t)(u.pm >> 4) * ADAW + col0;
        f32x4 gv[2][2];
#pragma unroll
        for (int bj = 0; bj < 2; ++bj) { gv[bj][0] = *(const f32x4*)(gp + bj * HALF); gv[bj][1] = *(const f32x4*)(gp + bj * HALF + 4); }
#pragma unroll
        for (int ai = 0; ai < 2; ++ai)
#pragma unroll
            for (int m = 0; m < 4; ++m) { const size_t off = (size_t)(row0 + ai * HALF + m * 16) * DM + col0;
#pragma unroll
                for (int bj = 0; bj < 2; ++bj) {
                    const f32x4 b0 = *(const f32x4*)(base + off + bj * HALF), b1 = *(const f32x4*)(base + off + bj * HALF + 4);
                    *(f32x4*)(out + off + bj * HALF) = b0 + gv[bj][0] * acc[ai][bj][m][0];
                    *(f32x4*)(out + off + bj * HALF + 4) = b1 + gv[bj][1] * acc[ai][bj][m][1]; }
                EPI_FENCE(); }
    }
};
struct EpiSwiglu {
    bf16_t* HM;
    __device__ __forceinline__ void operator()(const Acc& acc, const Unit& u, int wr, int wc, int fr, int fq) const {
        const int row0 = u.pm * BM + wr * 64 + fr, col0 = u.pn * HALF + wc * 32 + 8 * fq;
#pragma unroll
        for (int ai = 0; ai < 2; ++ai)
#pragma unroll
            for (int m = 0; m < 4; ++m) { float o[8];
#pragma unroll
                for (int n = 0; n < 2; ++n)
#pragma unroll
                    for (int j = 0; j < 4; ++j) { const float gg = acc[ai][0][m][n][j], uu = acc[ai][1][m][n][j]; o[4 * n + j] = gg * sigmoidf_(gg) * uu; }
                *(u32x4*)(HM + (size_t)(row0 + ai * HALF + m * 16) * DFF + col0) = pack8(o); }
    }
};
}

namespace att {
constexpr int NW = 8, QBLK = 32, KVBLK = 64, DV = 128, LDK = KVW;
constexpr int SHM_V = KVBLK * DV * 2;
constexpr int OFF_K = 2 * SHM_V, OFF_WS = 65536, OFF_Q = OFF_WS + 2048;
constexpr float THR = 8.f;
#define SBAR() __builtin_amdgcn_sched_barrier(0)
__device__ __forceinline__ int crow(int r, int hi) { return (r & 3) + 8 * (r >> 2) + 4 * hi; }
template <int DQK> __device__ __forceinline__ int kswz(int row, int colB) {
    if (DQK == 128) return row * 256 + (colB ^ ((row & 15) << 4));
    else return row * 128 + (colB ^ (((row >> 1) & 7) << 4));
}
template <bool FAST> __device__ __forceinline__ void partialSM(f32x16& p0, f32x16& p1, float& m_reg, float& mn, float& alpha) {
    if (!FAST) {
        constexpr float THR2 = THR * 1.4426950408889634f;
        float pmax = p0[0];
#pragma unroll
        for (int r = 1; r < 16; ++r) pmax = fmaxf(pmax, p0[r]);
#pragma unroll
        for (int r = 0; r < 16; ++r) pmax = fmaxf(pmax, p1[r]);
        { auto rr = __builtin_amdgcn_permlane32_swap(__float_as_uint(pmax), __float_as_uint(pmax), false, false);
          pmax = fmaxf(__uint_as_float(rr[0]), __uint_as_float(rr[1])); }
        if (__builtin_expect(__all(pmax - m_reg <= THR2), 1)) { mn = m_reg; alpha = 1.f; }
        else { mn = fmaxf(m_reg, pmax); alpha = __builtin_amdgcn_exp2f(m_reg - mn); m_reg = mn; }
#pragma unroll
        for (int r = 0; r < 16; ++r) p0[r] = p0[r] - mn;
#pragma unroll
        for (int r = 0; r < 16; ++r) p1[r] = p1[r] - mn;
    }
    if (FAST) SBAR();
#pragma unroll
    for (int r = 0; r < 16; ++r) p0[r] = __builtin_amdgcn_exp2f(p0[r]);
    if (FAST) SBAR();
}
template <bool FAST> __device__ __forceinline__ void finishSM(f32x16& p0, f32x16& p1, float alpha, float& l_reg, bf16x8& pa0, bf16x8& pa1, bf16x8& pa2, bf16x8& pa3) {
    if (FAST) SBAR();
#pragma unroll
    for (int r = 0; r < 16; ++r) p1[r] = __builtin_amdgcn_exp2f(p1[r]);
    float ps = 0;
    if (FAST) { float s0 = 0.f, s1 = 0.f, s2 = 0.f, s3 = 0.f;
#pragma unroll
        for (int r = 0; r < 16; r += 4) { s0 += p0[r] + p1[r]; s1 += p0[r + 1] + p1[r + 1]; s2 += p0[r + 2] + p1[r + 2]; s3 += p0[r + 3] + p1[r + 3]; }
        ps = (s0 + s1) + (s2 + s3); }
    else {
#pragma unroll
    for (int r = 0; r < 16; ++r) ps += p0[r];
#pragma unroll
    for (int r = 0; r < 16; ++r) ps += p1[r];
    }
    if (FAST) { SBAR(); l_reg += ps; }
    else { auto rr = __builtin_amdgcn_permlane32_swap(__float_as_uint(ps), __float_as_uint(ps), false, false);
           ps = __uint_as_float(rr[0]) + __uint_as_float(rr[1]); l_reg = l_reg * alpha + ps; }
#define PK4(P, BASE, OUT) do { unsigned a0 = cvt_pk_bf16(P[BASE + 0], P[BASE + 1]), a1 = cvt_pk_bf16(P[BASE + 2], P[BASE + 3]);   \
    unsigned b0 = cvt_pk_bf16(P[BASE + 4], P[BASE + 5]), b1 = cvt_pk_bf16(P[BASE + 6], P[BASE + 7]);                              \
    auto r0 = __builtin_amdgcn_permlane32_swap(a0, b0, false, false); auto r1 = __builtin_amdgcn_permlane32_swap(a1, b1, false, false); \
    u32x4 w = {r0[0], r1[0], r0[1], r1[1]}; OUT = __builtin_bit_cast(bf16x8, w); } while (0)
    PK4(p0, 0, pa0); PK4(p0, 8, pa1); PK4(p1, 0, pa2); PK4(p1, 8, pa3);
#undef PK4
}
template <int DQK> __device__ __forceinline__ void qkt(f32x16& p0, f32x16& p1, const char* Ks, const bf16x8* qr, int r32, int hi) {
    p0 = f32x16{}; p1 = f32x16{};
#pragma unroll
    for (int d0 = 0; d0 < DQK / 16; ++d0) { const int cb = (d0 * 16 + hi * 8) * 2, ci = 0;
        const bf16x8 b0 = *reinterpret_cast<const bf16x8*>(Ks + kswz<DQK>(r32, cb) + ci);
        const bf16x8 b1 = *reinterpret_cast<const bf16x8*>(Ks + kswz<DQK>(r32, cb) + ci + 32 * (DQK * 2));
        p0 = __builtin_amdgcn_mfma_f32_32x32x16_bf16(b0, qr[d0], p0, 0, 0, 0);
        p1 = __builtin_amdgcn_mfma_f32_32x32x16_bf16(b1, qr[d0], p1, 0, 0, 0); }
}
template <int DQK, int NREG> __device__ __forceinline__ void qkt_mix(f32x16& p0, f32x16& p1, const char* Ks, const bf16x8* qr, const char* qs, int r32, int hi) {
    p0 = f32x16{}; p1 = f32x16{};
#pragma unroll
    for (int d0 = 0; d0 < DQK / 16; ++d0) { const int cb = (d0 * 16 + hi * 8) * 2, ci = 0;
        const bf16x8 b0 = *reinterpret_cast<const bf16x8*>(Ks + kswz<DQK>(r32, cb) + ci);
        const bf16x8 b1 = *reinterpret_cast<const bf16x8*>(Ks + kswz<DQK>(r32, cb) + ci + 32 * (DQK * 2));
        bf16x8 q; if (d0 < NREG) q = qr[d0]; else q = *reinterpret_cast<const bf16x8*>(qs + (d0 - NREG) * 1024);
        p0 = __builtin_amdgcn_mfma_f32_32x32x16_bf16(b0, q, p0, 0, 0, 0);
        p1 = __builtin_amdgcn_mfma_f32_32x32x16_bf16(b1, q, p1, 0, 0, 0); }
}
template <int DQK> __device__ __forceinline__ void qkt_ld(f32x16& p0, f32x16& p1, const char* Ks, const bf16_t* qw, int r32, int hi) {
    p0 = f32x16{}; p1 = f32x16{};
#pragma unroll
    for (int d0 = 0; d0 < DQK / 16; ++d0) { const int cb = (d0 * 16 + hi * 8) * 2, ci = 0;
        const bf16x8 q = *(const bf16x8*)(qw + d0 * 16);
        const bf16x8 b0 = *reinterpret_cast<const bf16x8*>(Ks + kswz<DQK>(r32, cb) + ci);
        const bf16x8 b1 = *reinterpret_cast<const bf16x8*>(Ks + kswz<DQK>(r32, cb) + ci + 32 * (DQK * 2));
        p0 = __builtin_amdgcn_mfma_f32_32x32x16_bf16(b0, q, p0, 0, 0, 0);
        p1 = __builtin_amdgcn_mfma_f32_32x32x16_bf16(b1, q, p1, 0, 0, 0); SBAR(); }
}
__device__ __forceinline__ int v_st(int k, int c) { const int kk = (k & ~0xC) | ((k & 4) << 1) | ((k & 8) >> 1); return ((kk >> 3) * 4 + (c >> 5)) * 512 + ((kk & 7) * 32 + (c & 31)) * 2; }
__device__ __forceinline__ int v_rd_base(int lane) { return ((lane & 3) << 3) | (((lane >> 2) & 3) << 6) | (((lane >> 4) & 1) << 5) | (((lane >> 5) & 1) << 8); }
constexpr int v_rd_off(int d0, int ks, int half) { return d0 * 512 + ks * 4096 + half * 2048; }
template <int OFF> __device__ __forceinline__ s16x4 tr_read(int vb) {
    s16x4 r; asm volatile("ds_read_b64_tr_b16 %0, %1 offset:%2" : "=&v"(r) : "v"(vb), "i"(OFF) : "memory"); return r;
}
template <int D0> __device__ __forceinline__ void pv_one(f32x16& od, int vb, bf16x8 pa0, bf16x8 pa1, bf16x8 pa2, bf16x8 pa3) {
    const s16x4 l0 = tr_read<v_rd_off(D0, 0, 0)>(vb), h0 = tr_read<v_rd_off(D0, 0, 1)>(vb), l1 = tr_read<v_rd_off(D0, 1, 0)>(vb), h1 = tr_read<v_rd_off(D0, 1, 1)>(vb);
    const s16x4 l2 = tr_read<v_rd_off(D0, 2, 0)>(vb), h2 = tr_read<v_rd_off(D0, 2, 1)>(vb), l3 = tr_read<v_rd_off(D0, 3, 0)>(vb), h3 = tr_read<v_rd_off(D0, 3, 1)>(vb);
    asm volatile("s_waitcnt lgkmcnt(0)" ::: "memory"); SBAR();
#define PK(L, H) (bf16x8){L[0], L[1], L[2], L[3], H[0], H[1], H[2], H[3]}
    od = __builtin_amdgcn_mfma_f32_32x32x16_bf16(pa0, PK(l0, h0), od, 0, 0, 0);
    od = __builtin_amdgcn_mfma_f32_32x32x16_bf16(pa1, PK(l1, h1), od, 0, 0, 0);
    od = __builtin_amdgcn_mfma_f32_32x32x16_bf16(pa2, PK(l2, h2), od, 0, 0, 0);
    od = __builtin_amdgcn_mfma_f32_32x32x16_bf16(pa3, PK(l3, h3), od, 0, 0, 0);
#undef PK
}
__device__ __forceinline__ void pv_d0(f32x16* o, int vb, bf16x8 pa0, bf16x8 pa1, bf16x8 pa2, bf16x8 pa3) {
    pv_one<0>(o[0], vb, pa0, pa1, pa2, pa3); pv_one<1>(o[1], vb, pa0, pa1, pa2, pa3); pv_one<2>(o[2], vb, pa0, pa1, pa2, pa3); pv_one<3>(o[3], vb, pa0, pa1, pa2, pa3);
}

template <int DQK, int LDQ, int LDO, bool FAST, int SD>
__device__ __forceinline__ void attn_unit(const bf16_t* Qb, const bf16_t* __restrict__ Kh, const bf16_t* __restrict__ Vh, bf16_t* Ob,
                                          char* lds) {
    constexpr int SHM_K = KVBLK * DQK * 2, ND0 = DQK / 16;
    int tid_ = threadIdx.x; asm volatile("" : "+v"(tid_));
    const int tid = tid_, wid = tid >> 6, lane = tid & 63, r32 = lane & 31, hi = lane >> 5;
    char* V_lds = lds; char* K_lds = lds + OFF_K;
    float* ws = (float*)(lds + OFF_WS) + wid * 64; float* li_l = ws; float* al_l = ws + 32;
    float m_reg = -1e30f, l_reg = 0; f32x16 o[4] = {};
    const bf16_t* Qw0 = Qb + (size_t)(wid * QBLK + r32) * LDQ + hi * 8;
#define QLOAD() const bf16_t* qw_ = Qw0; asm volatile("" : "+v"(qw_))
    const int sr = tid >> 4, sc = (tid & 15) * 8, vst0 = v_st(sr, sc), vst1 = v_st(32 + sr, sc);
    const int krow = (DQK == 128) ? sr : (tid >> 3), kcol = (DQK == 128) ? sc : (tid & 7) * 8;
    const int kst0 = kswz<DQK>(krow, kcol * 2), kst1 = kswz<DQK>(32 + krow, kcol * 2);
    const int vb0 = (int)(uintptr_t)V_lds + v_rd_base(lane);
    struct { bf16x8 vs0, vs1, ks0, ks1; } sr_[SD];
#define SLOAD(i, k0) do { sr_[i].vs0 = *(const bf16x8*)(&Vh[(size_t)((k0) + sr) * LDK + sc]); sr_[i].vs1 = *(const bf16x8*)(&Vh[(size_t)((k0) + 32 + sr) * LDK + sc]); \
    sr_[i].ks0 = *(const bf16x8*)(&Kh[(size_t)((k0) + krow) * LDK + kcol]); if (DQK == 128) sr_[i].ks1 = *(const bf16x8*)(&Kh[(size_t)((k0) + 32 + krow) * LDK + kcol]); } while (0)
#define SWRITE(b, i) do { *(bf16x8*)(V_lds + (b) * SHM_V + vst0) = sr_[i].vs0; *(bf16x8*)(V_lds + (b) * SHM_V + vst1) = sr_[i].vs1; \
    *(bf16x8*)(K_lds + (b) * SHM_K + kst0) = sr_[i].ks0; if (DQK == 128) *(bf16x8*)(K_lds + (b) * SHM_K + kst1) = sr_[i].ks1; } while (0)
#define SWAIT() do { if (SD == 1) asm volatile("s_waitcnt vmcnt(0)" ::: "memory"); else if (DQK == 128) asm volatile("s_waitcnt vmcnt(4)" ::: "memory"); else asm volatile("s_waitcnt vmcnt(3)" ::: "memory"); } while (0)
#define RESC(a) do { if (!FAST && __any((a) < 1.f)) { if (hi == 0) al_l[r32] = (a); asm volatile("s_waitcnt lgkmcnt(0)" ::: "memory"); \
    _Pragma("unroll") for (int d = 0; d < 4; ++d) _Pragma("unroll") for (int r = 0; r < 16; ++r) o[d][r] *= al_l[crow(r, hi)]; } } while (0)
    f32x16 pA0, pA1, pB0, pB1; float mnA, mnB, alA, alB; bf16x8 pa0, pa1, pa2, pa3; constexpr int NT = SKV / KVBLK;
    constexpr int SE = 0, SO = SD - 1;
    SLOAD(SE, 0); asm volatile("s_waitcnt vmcnt(0)" ::: "memory"); SWRITE(0, SE); __syncthreads();
    { QLOAD(); qkt_ld<DQK>(pA0, pA1, K_lds, qw_, r32, hi); } partialSM<FAST>(pA0, pA1, m_reg, mnA, alA);
    SLOAD(SO, KVBLK); if (SD == 2) SLOAD(SE, 2 * KVBLK);
    SWAIT(); SWRITE(1, SO); __syncthreads();
    for (int j = 1; j + 1 < NT; j += 2) {
        SBAR(); { QLOAD(); qkt_ld<DQK>(pB0, pB1, K_lds + SHM_K, qw_, r32, hi); }
        finishSM<FAST>(pA0, pA1, alA, l_reg, pa0, pa1, pa2, pa3); SBAR();
        SLOAD(SO, (j + SD) * KVBLK); SBAR();
        pv_d0(o, vb0, pa0, pa1, pa2, pa3); partialSM<FAST>(pB0, pB1, m_reg, mnB, alB);
        __syncthreads(); SWAIT(); SWRITE(0, SE);
        RESC(alB); __syncthreads();
        SBAR(); { QLOAD(); qkt_ld<DQK>(pA0, pA1, K_lds, qw_, r32, hi); }
        finishSM<FAST>(pB0, pB1, alB, l_reg, pa0, pa1, pa2, pa3); SBAR();
        if (SD == 1 || j + 3 < NT) SLOAD(SE, (j + 1 + SD) * KVBLK); SBAR();
        pv_d0(o, vb0 + SHM_V, pa0, pa1, pa2, pa3); partialSM<FAST>(pA0, pA1, m_reg, mnA, alA);
        __syncthreads(); SWAIT(); SWRITE(1, SO);
        RESC(alA); __syncthreads();
    }
    SBAR(); { QLOAD(); qkt_ld<DQK>(pB0, pB1, K_lds + SHM_K, qw_, r32, hi); }
    finishSM<FAST>(pA0, pA1, alA, l_reg, pa0, pa1, pa2, pa3); SBAR();
    pv_d0(o, vb0, pa0, pa1, pa2, pa3); partialSM<FAST>(pB0, pB1, m_reg, mnB, alB);
    __syncthreads(); RESC(alB);
    finishSM<FAST>(pB0, pB1, alB, l_reg, pa0, pa1, pa2, pa3); SBAR();
    pv_d0(o, vb0 + SHM_V, pa0, pa1, pa2, pa3);
    if (FAST) { auto rr = __builtin_amdgcn_permlane32_swap(__float_as_uint(l_reg), __float_as_uint(l_reg), false, false); l_reg = __uint_as_float(rr[0]) + __uint_as_float(rr[1]); }
    if (hi == 0) li_l[r32] = l_reg; asm volatile("s_waitcnt lgkmcnt(0)" ::: "memory");
    float rli[16];
#pragma unroll
    for (int r = 0; r < 16; ++r) rli[r] = __builtin_amdgcn_rcpf(li_l[crow(r, hi)]);
    __syncthreads();
    {
        bf16_t* stg = (bf16_t*)lds + wid * 4096;
#pragma unroll
        for (int r = 0; r < 16; ++r) { const int orow = crow(r, hi);
#pragma unroll
            for (int d0 = 0; d0 < 4; ++d0) { const float v = o[d0][r] * rli[r]; stg[orow * 128 + d0 * 32 + r32] = (bf16_t)(cvt_pk_bf16(v, v) & 0xffffu); } }
        asm volatile("s_waitcnt lgkmcnt(0)" ::: "memory");
        bf16_t* Ow = Ob + (size_t)(wid * QBLK) * LDO;
#pragma unroll
        for (int i = 0; i < 8; ++i) { const int row = i * 4 + (lane >> 4), ch = lane & 15; const u32x4 v = *(const u32x4*)(stg + row * 128 + ch * 8);
            *(u32x4*)(Ow + (size_t)row * LDO + ch * 8) = v; }
    }
    __syncthreads();
#undef QLOAD
#undef SLOAD
#undef SWRITE
#undef SWAIT
#undef RESC
}

__device__ __forceinline__ void glds16(const void* gsrc, unsigned lds_dst) { unsigned keep;
    asm volatile("s_mov_b32 %0, m0\n\ts_mov_b32 m0, %2\n\ts_nop 0\n\tglobal_load_lds_dwordx4 %1, off\n\ts_mov_b32 m0, %0" : "=&s"(keep) : "v"(gsrc), "s"(lds_dst) : "memory"); }
template <int DQK, int LDQ, int LDO>
__device__ __forceinline__ void attn_unit_fast(const bf16_t* Qb, const bf16_t* __restrict__ Kh, const bf16_t* __restrict__ Vh, bf16_t* Ob, char* lds,
                                               int mode = 0, float lam = 0.f, const float* __restrict__ sg = nullptr) {
    constexpr int SHM_K = KVBLK * DQK * 2, ND0 = DQK / 16, NT = SKV / KVBLK;
    constexpr int NQL = (DQK == 128) ? 2 : 0, NREG = ND0 - NQL;
    constexpr bool EARLY = (DQK == 64);
    static_assert(NT % 2 == 0 && NT >= 4, "even tile count");
    int tid_ = threadIdx.x; if (DQK == 128) asm volatile("" : "+v"(tid_));
    const int tid = tid_, wid = tid >> 6, lane = tid & 63, r32 = lane & 31, hi = lane >> 5;
    const bool isY = false;
    char* V_lds = lds; char* K_lds = lds + OFF_K;
    float l_reg = 0, dummy_m = 0, dummy_a = 1.f; f32x16 o[4] = {}; bf16x8 qr[NREG];
    char* qs = lds + OFF_Q + wid * (2 * 1024) + lane * 16;
    {
        const bf16_t* Qw = Qb + (size_t)(wid * QBLK + r32) * LDQ + hi * 8;
#pragma unroll
        for (int d0 = 0; d0 < NREG; ++d0) qr[d0] = *(const bf16x8*)(Qw + d0 * 16);
#pragma unroll
        for (int d0 = NREG; d0 < ND0; ++d0) *(bf16x8*)(qs + (d0 - NREG) * 1024) = *(const bf16x8*)(Qw + d0 * 16);
    }
    const int widu = __builtin_amdgcn_readfirstlane(wid);
    const int vb0 = (int)(uintptr_t)V_lds + v_rd_base(lane);
    unsigned ksrc[2], vsrc[2];
#pragma unroll
    for (int i = 0; i < 2; ++i) {
        if (DQK == 128) { const int j = wid * 2 + i, row = 4 * j + (lane >> 4), c = (lane & 15) ^ (row & 15); ksrc[i] = (unsigned)(row * LDK + c * 8) * 2u; }
        else { const int row = 8 * wid + (lane >> 3), c = (lane & 7) ^ ((row >> 1) & 7); ksrc[i] = (unsigned)(row * LDK + c * 8) * 2u; }
        const int j = wid * 2 + i, st = 2 * j + (lane >> 5), kk = (st >> 2) * 8 + ((lane & 31) >> 2), c = (st & 3) * 32 + (lane & 3) * 8;
        const int k = (kk & ~0xC) | ((kk & 4) << 1) | ((kk & 8) >> 1);
        vsrc[i] = (unsigned)(k * LDK + c) * 2u;
    }
    constexpr size_t TILEB = (size_t)KVBLK * LDK * 2;
    const unsigned lds0 = (unsigned)(uintptr_t)lds;
#define DMA_K(t, buf) do { const char* kb_ = (const char*)Kh + (size_t)(t) * TILEB; \
        glds16(kb_ + ksrc[0], (unsigned)__builtin_amdgcn_readfirstlane(lds0 + OFF_K + (buf) * SHM_K + (DQK == 128 ? widu * 2048 : widu * 1024))); \
        if (DQK == 128) glds16(kb_ + ksrc[1], (unsigned)__builtin_amdgcn_readfirstlane(lds0 + OFF_K + (buf) * SHM_K + widu * 2048 + 1024)); } while (0)
#define DMA_V(t, buf) do { const char* vb_ = (const char*)Vh + (size_t)(t) * TILEB; \
        glds16(vb_ + vsrc[0], (unsigned)__builtin_amdgcn_readfirstlane(lds0 + (buf) * SHM_V + widu * 2048)); \
        glds16(vb_ + vsrc[1], (unsigned)__builtin_amdgcn_readfirstlane(lds0 + (buf) * SHM_V + widu * 2048 + 1024)); } while (0)
#define WBAR0() do { asm volatile("s_waitcnt vmcnt(0)" ::: "memory"); __syncthreads(); } while (0)
#define EXPH(P) do { _Pragma("unroll") for (int r = 0; r < 16; ++r) P[r] = __builtin_amdgcn_exp2f(P[r]); } while (0)
    f32x16 pA0, pA1, pB0, pB1; bf16x8 pa0, pa1, pa2, pa3;
    DMA_K(0, 0); DMA_K(1, 1); DMA_V(0, 0); WBAR0();
    if (__builtin_amdgcn_readfirstlane(tid_) >= 256) __builtin_amdgcn_s_setprio(1);
    qkt_mix<DQK, NREG>(pA0, pA1, K_lds, qr, qs, r32, hi); if (!isY) { EXPH(pA0); }
    __syncthreads();
    for (int k = 1; k + 1 < NT; k += 2) {
        DMA_K(k + 1, 0); DMA_V(k, 1); SBAR();
        if (isY) { EXPH(pA0); }
        SBAR(); qkt_mix<DQK, NREG>(pB0, pB1, K_lds + SHM_K, qr, qs, r32, hi);
        finishSM<true>(pA0, pA1, dummy_a, l_reg, pa0, pa1, pa2, pa3); SBAR();
        pv_d0(o, vb0, pa0, pa1, pa2, pa3);
        if (!isY) { EXPH(pB0); }
        WBAR0();
        DMA_K(k + 2, 1); DMA_V(k + 1, 0); SBAR();
        if (isY) { EXPH(pB0); }
        SBAR(); qkt_mix<DQK, NREG>(pA0, pA1, K_lds, qr, qs, r32, hi);
        finishSM<true>(pB0, pB1, dummy_a, l_reg, pa0, pa1, pa2, pa3); SBAR();
        pv_d0(o, vb0 + SHM_V, pa0, pa1, pa2, pa3);
        if (!isY) { EXPH(pA0); }
        WBAR0();
    }
    DMA_V(NT - 1, 1); SBAR();
    if (isY) { EXPH(pA0); }
    SBAR(); qkt_mix<DQK, NREG>(pB0, pB1, K_lds + SHM_K, qr, qs, r32, hi);
    finishSM<true>(pA0, pA1, dummy_a, l_reg, pa0, pa1, pa2, pa3); SBAR();
    pv_d0(o, vb0, pa0, pa1, pa2, pa3);
    if (!isY) { EXPH(pB0); }
    WBAR0();
    if (isY) { EXPH(pB0); }
    SBAR(); finishSM<true>(pB0, pB1, dummy_a, l_reg, pa0, pa1, pa2, pa3); SBAR();
    pv_d0(o, vb0 + SHM_V, pa0, pa1, pa2, pa3);
    __builtin_amdgcn_s_setprio(0);
    (void)dummy_m;
    { auto rr = __builtin_amdgcn_permlane32_swap(__float_as_uint(l_reg), __float_as_uint(l_reg), false, false); l_reg = __uint_as_float(rr[0]) + __uint_as_float(rr[1]); }
    {
        int t2 = threadIdx.x; asm volatile("" : "+v"(t2));
        const int wid2 = t2 >> 6, lane2 = t2 & 63, r32b = lane2 & 31, hib = lane2 >> 5;
        float* li2 = (float*)(lds + OFF_WS) + wid2 * 64;
        if (hib == 0) li2[r32b] = l_reg; asm volatile("s_waitcnt lgkmcnt(0)" ::: "memory");
        __syncthreads();
        bf16_t* stash = (bf16_t*)(lds + OFF_Q) + wid2 * 4096;
        bf16_t* stg = (mode == 1) ? stash : ((bf16_t*)lds + wid2 * 4096);
#pragma unroll
        for (int r = 0; r < 16; ++r) { const int orow = crow(r, hib); const float rl = __builtin_amdgcn_rcpf(li2[orow]);
#pragma unroll
            for (int d0 = 0; d0 < 4; ++d0) { const float v = o[d0][r] * rl; stg[orow * 128 + d0 * 32 + r32b] = (bf16_t)(cvt_pk_bf16(v, v) & 0xffffu); } }
        asm volatile("s_waitcnt lgkmcnt(0)" ::: "memory");
        if (mode != 1) {
            bf16_t* Ow = Ob + (size_t)(wid2 * QBLK) * LDO;
            const int ch = lane2 & 15;
            float gg[8];
            if (mode == 2) {
#pragma unroll
                for (int e = 0; e < 8; ++e) gg[e] = sg[ch * 8 + e] * 0.8f; }
#pragma unroll
            for (int i = 0; i < 8; ++i) { const int row = i * 4 + (lane2 >> 4); u32x4 v = *(const u32x4*)(stg + row * 128 + ch * 8);
                if (mode == 2) { const u32x4 v0 = *(const u32x4*)(stash + row * 128 + ch * 8); float x0[8], x1[8]; unpack8(v0, x0); unpack8(v, x1); float ss = 0.f;
#pragma unroll
                    for (int e = 0; e < 8; ++e) { x0[e] = x0[e] - lam * x1[e]; ss += x0[e] * x0[e]; }
                    ss += __shfl_xor(ss, 1); ss += __shfl_xor(ss, 2); ss += __shfl_xor(ss, 4); ss += __shfl_xor(ss, 8);
                    const float rstd = rsqrtf(ss * (1.0f / 128) + EPS);
#pragma unroll
                    for (int e = 0; e < 8; ++e) x0[e] = x0[e] * rstd * gg[e];
                    v = pack8(x0); }
                *(u32x4*)(Ow + (size_t)row * LDO + ch * 8) = v; }
        }
    }
    asm volatile("s_waitcnt vmcnt(0)" ::: "memory");
    __syncthreads();
#undef DMA_K
#undef DMA_V
#undef WBAR0
#undef EXPH
}
#undef SBAR
}

struct Args { const float* in[24]; float* out; unsigned char* ws; int ph_lo, ph_hi; };
enum { I_X = 0, I_C, I_CTX, I_CCTX, I_WADA, I_BADA, I_N1G, I_WIN, I_QNA, I_KNA, I_QNB, I_KNB, I_LQ1, I_LK1, I_LQ2, I_LK2, I_SUBLN, I_WBRA, I_WBRB, I_WOUT, I_N2G, I_WFG, I_WFU, I_WFD };
constexpr int NPHASES = 11;

__device__ __forceinline__ void transpose_item(const float* W, int K, int N, bf16_t* WT, int gu, LAS float* scr, int item, int lane) {
    const int nblk = N / 32, kb = item / nblk, nb = item % nblk, k0 = 64 * kb, n0 = 32 * nb;
#pragma unroll 8
    for (int i = 0; i < 32; ++i) { const int kk = 2 * i + (lane >> 5); scr[kk * 33 + (lane & 31)] = W[(size_t)(k0 + kk) * N + n0 + (lane & 31)]; }
    asm volatile("s_waitcnt lgkmcnt(0)" ::: "memory");
    const int c = lane & 7;
    const int rbase = (gu == 0 || gu == 3) ? n0 : (((n0 >> 7) << 8) + (n0 & 127) + (gu == 2 ? 128 : 0));
    const int hk = (gu != 3) ? 0 : ((n0 < 512 || (n0 >= 3072 && n0 < 5120)) ? 1 : (((n0 >= 1024 && n0 < 2048) || (n0 >= 5120 && n0 < 6144)) ? 2 : 0));
#pragma unroll
    for (int j = 0; j < 4; ++j) { const int n = (lane >> 3) + 8 * j; const LAS float* s = scr + (8 * c) * 33 + n;
        int rown = rbase + n;
        if (hk == 1) { const int i = (n0 & 127) + n; rown = (n0 & ~127) + ((i < 64) ? 2 * i : 2 * (i - 64) + 1); }
        else if (hk == 2) { const int i = (n0 & 63) + n; rown = (n0 & ~63) + ((i < 32) ? 2 * i : 2 * (i - 32) + 1); }
        u32x4 o; o.x = cvt_pk_bf16(s[0 * 33], s[1 * 33]); o.y = cvt_pk_bf16(s[2 * 33], s[3 * 33]); o.z = cvt_pk_bf16(s[4 * 33], s[5 * 33]); o.w = cvt_pk_bf16(s[6 * 33], s[7 * 33]);
        *(u32x4*)(WT + (size_t)rown * K + k0 + 8 * c) = o; }
    asm volatile("s_waitcnt lgkmcnt(0)" ::: "memory");
}

__device__ __forceinline__ void norm_chunk(const float* X, bf16_t* OUT, int row0, const LAS float* mA, const LAS float* mS, int wave, int lane, int rpw = 8) {
    for (int r = 0; r < rpw; ++r) {
        const int row = row0 + wave * rpw + r;
        const f32x4* xr = (const f32x4*)(X + (size_t)row * DM) + lane;
        f32x4 v[8]; float ss = 0.f;
#pragma unroll
        for (int j = 0; j < 8; ++j) { v[j] = xr[64 * j]; ss += (v[j].x * v[j].x + v[j].y * v[j].y) + (v[j].z * v[j].z + v[j].w * v[j].w); }
        ss = wave_sum(ss);
        const float rstd = rsqrtf(ss * (1.0f / DM) + EPS);
        u32x2* op = (u32x2*)(OUT + (size_t)row * DM) + lane;
#pragma unroll
        for (int j = 0; j < 8; ++j) { const int col = 4 * lane + 256 * j; const f32x4 a = *(const LAS f32x4*)(mA + col), s = *(const LAS f32x4*)(mS + col);
            const f32x4 ov = v[j] * rstd * a + s; u32x2 w; w.x = cvt_pk_bf16(ov.x, ov.y); w.y = cvt_pk_bf16(ov.z, ov.w); op[64 * j] = w; }
    }
}

__device__ __forceinline__ void nr128(bf16_t* p, const float* g, bool rope, float prow, float pcol, int lane, float osc) {
    const u32x4 raw = *(const u32x4*)p; float x[8]; unpack8(raw, x); float ss = 0.f;
#pragma unroll
    for (int e = 0; e < 8; ++e) ss += x[e] * x[e];
    ss += __shfl_xor(ss, 1); ss += __shfl_xor(ss, 2); ss += __shfl_xor(ss, 4); ss += __shfl_xor(ss, 8);
    const float rstd = rsqrtf(ss * (1.0f / 128) + EPS); const int idx0 = (lane & 15) * 8;
#pragma unroll
    for (int e = 0; e < 8; ++e) x[e] = x[e] * rstd * g[idx0 + e];
    if (rope) { const bool lo_half = (lane & 8) == 0; const int i0 = idx0 & 63;
#pragma unroll
        for (int e = 0; e < 8; ++e) { const float pp = __shfl_xor(x[e], 8); const int i = i0 + e, f = i & 31;
            const float ang = ((i < 32) ? prow : pcol) * __builtin_amdgcn_exp2f(-(float)f * (13.287712379549449f / 32));
            const float c = __cosf(ang), sn = __sinf(ang);
            x[e] = lo_half ? (x[e] * c - pp * sn) : (x[e] * c + pp * sn); } }
#pragma unroll
    for (int e = 0; e < 8; ++e) x[e] *= osc;
    *(u32x4*)p = pack8(x);
}
__device__ __forceinline__ void nr64(bf16_t* p, const float* g, bool rope, float prow, float pcol, int lane, float osc) {
    const u32x4 raw = *(const u32x4*)p; float x[8]; unpack8(raw, x); float ss = 0.f;
#pragma unroll
    for (int e = 0; e < 8; ++e) ss += x[e] * x[e];
    ss += __shfl_xor(ss, 1); ss += __shfl_xor(ss, 2); ss += __shfl_xor(ss, 4);
    const float rstd = rsqrtf(ss * (1.0f / 64) + EPS); const int idx0 = (lane & 7) * 8;
#pragma unroll
    for (int e = 0; e < 8; ++e) x[e] = x[e] * rstd * g[idx0 + e];
    if (rope) { const bool lo_half = (lane & 4) == 0; const int i0 = idx0 & 31;
#pragma unroll
        for (int e = 0; e < 8; ++e) { const float pp = __shfl_xor(x[e], 4); const int i = i0 + e, f = i & 15;
            const float ang = ((i < 16) ? prow : pcol) * __builtin_amdgcn_exp2f(-(float)f * (13.287712379549449f / 16));
            const float c = __cosf(ang), sn = __sinf(ang);
            x[e] = lo_half ? (x[e] * c - pp * sn) : (x[e] * c + pp * sn); } }
#pragma unroll
    for (int e = 0; e < 8; ++e) x[e] *= osc;
    *(u32x4*)p = pack8(x);
}

__device__ __forceinline__ void light_grid_barrier(unsigned* ctr, unsigned target) {
    asm volatile("s_waitcnt vmcnt(0)" ::: "memory");
    __syncthreads();
    if (threadIdx.x == 0) {
        __builtin_amdgcn_fence(__ATOMIC_RELEASE, "agent");
        asm volatile("s_waitcnt vmcnt(0)" ::: "memory");
        (void)__hip_atomic_fetch_add(ctr, 1u, __ATOMIC_RELAXED, __HIP_MEMORY_SCOPE_AGENT);
        unsigned spins = 0;
        while (__hip_atomic_load(ctr, __ATOMIC_RELAXED, __HIP_MEMORY_SCOPE_AGENT) < target) { __builtin_amdgcn_s_sleep(2); if (++spins > (1u << 23)) break; }
        __builtin_amdgcn_fence(__ATOMIC_ACQUIRE, "agent");
        asm volatile("s_waitcnt vmcnt(0)" ::: "memory");
    }
    __syncthreads();
}

#define XB_TMO      128
#define XB_XCNT(j)  (256  + 64 * (j))
#define XB_XSUB(j)  (1280 + 64 * (j))
#define XB_XGEN(j)  (2304 + 64 * (j))
#define XB_TOP      3328
#define XB_TOPGEN   3392
#define XCD_BAR_WORDS 3456
#define XB_SPIN_CAP (1u << 18)
__device__ __forceinline__ unsigned xb_ld(unsigned* p)              { return __hip_atomic_load(p, __ATOMIC_RELAXED, __HIP_MEMORY_SCOPE_AGENT); }
__device__ __forceinline__ unsigned xb_add(unsigned* p, unsigned v) { return __hip_atomic_fetch_add(p, v, __ATOMIC_RELAXED, __HIP_MEMORY_SCOPE_AGENT); }
__device__ __forceinline__ unsigned xb_xcc_id() { return (unsigned)__builtin_amdgcn_s_getreg((3 << 11) | 20) & 0xFu; }
#define XB_SPIN(cond, bar) do { unsigned _sp = 0; while (cond) { __builtin_amdgcn_s_sleep(1); \
    if ((++_sp & 255u) == 0u) { if (xb_ld(&(bar)[XB_TMO])) break; if (_sp > XB_SPIN_CAP) { atomicAdd(&(bar)[XB_TMO], 1u); break; } } } } while (0)
struct XcdBarrier { unsigned* bar; unsigned x; volatile LAS unsigned* st; };
__device__ __forceinline__ XcdBarrier xcd_barrier_post(unsigned* bar, volatile LAS unsigned* st) {
    XcdBarrier b; b.bar = bar; b.x = xb_xcc_id(); b.st = st;
    if (threadIdx.x == 0) (void)xb_add(&bar[XB_XCNT(b.x)], 1u);
    return b;
}
__device__ __forceinline__ void xcd_barrier_complete(unsigned* bar, unsigned x, unsigned& nloc, unsigned& nx) {
    const unsigned G = gridDim.x * gridDim.y * gridDim.z;
    unsigned sum, cnt, mine, sp = 0u;
    for (;;) {
        sum = 0u; cnt = 0u; mine = 0u;
#pragma unroll
        for (unsigned j = 0; j < 16; ++j) { const unsigned c = xb_ld(&bar[XB_XCNT(j)]); sum += c; cnt += (c > 0u) ? 1u : 0u; mine = (j == x) ? c : mine; }
        if (sum == G) break;
        __builtin_amdgcn_s_sleep(1);
        if ((++sp & 255u) == 0u) { if (xb_ld(&bar[XB_TMO])) break; if (sp > XB_SPIN_CAP) { atomicAdd(&bar[XB_TMO], 1u); break; } }
    }
    nloc = mine > 0u ? mine : 1u; nx = cnt > 0u ? cnt : 1u;
}
__device__ __forceinline__ void xcd_barrier(const XcdBarrier& b) {
    asm volatile("s_waitcnt vmcnt(0)" ::: "memory");
    __syncthreads();
    if (threadIdx.x == 0) {
        unsigned* bar = b.bar;
        __builtin_amdgcn_s_waitcnt(0);
        unsigned nloc = b.st[0], nx = b.st[1];
        if (nloc == 0u) { xcd_barrier_complete(bar, b.x, nloc, nx); b.st[0] = nloc; b.st[1] = nx; }
        const unsigned old = xb_add(&bar[XB_XSUB(b.x)], 1u);
        const unsigned gen = old / nloc;
        if (old + 1u == (gen + 1u) * nloc) {
            __builtin_amdgcn_fence(__ATOMIC_RELEASE, "agent");
            asm volatile("s_waitcnt vmcnt(0)" ::: "memory");
            const unsigned og = xb_add(&bar[XB_TOP], 1u);
            const unsigned tg = og / nx;
            if (og + 1u == (tg + 1u) * nx) xb_add(&bar[XB_TOPGEN], 1u);
            else XB_SPIN(xb_ld(&bar[XB_TOPGEN]) == tg, bar);
            __builtin_amdgcn_fence(__ATOMIC_ACQUIRE, "agent");
            xb_add(&bar[XB_XGEN(b.x)], 1u);
            asm volatile("s_waitcnt vmcnt(0)" ::: "memory");
        } else {
            XB_SPIN(xb_ld(&bar[XB_XGEN(b.x)]) == gen, bar);
            __builtin_amdgcn_fence(__ATOMIC_ACQUIRE, "agent");
            asm volatile("s_waitcnt vmcnt(0)" ::: "memory");
        }
    }
    __syncthreads();
}

__global__ void __launch_bounds__(NTHREADS, 2) fwd_kernel(Args a) {
    extern __shared__ __attribute__((aligned(16))) unsigned char lds[];
    LAS unsigned char* ldsl = (LAS unsigned char*)lds;
    const int G = gridDim.x, bx = blockIdx.x;
#define PHASE_IDS() int tid = threadIdx.x; asm volatile("" : "+v"(tid)); const int lane = tid & 63, wave = __builtin_amdgcn_readfirstlane(tid >> 6); (void)lane; (void)wave
    const int vcu = (G % 8 == 0) ? (bx % 8) * (G / 8) + bx / 8 : bx;
    unsigned char* ws = a.ws;
    float* MODP = (float*)(ws + WS_MODP); float* MOD = (float*)(ws + WS_MOD);
    bf16_t* WinT = (bf16_t*)(ws + WS_WIN); bf16_t* WdT = (bf16_t*)(ws + WS_WD); bf16_t* WbrAT = (bf16_t*)(ws + WS_WBRA); bf16_t* WbrBT = (bf16_t*)(ws + WS_WBRB);
    bf16_t* WoutT = (bf16_t*)(ws + WS_WOUT); bf16_t* WguT = (bf16_t*)(ws + WS_WGU);
    bf16_t* Hb = (bf16_t*)(ws + WS_H); bf16_t* KV = (bf16_t*)(ws + WS_KV); bf16_t* QG = (bf16_t*)(ws + WS_QG);
    bf16_t* OBraw = Hb; bf16_t* Tm = KV; bf16_t* HM = QG; bf16_t* H2 = Hb;
    const int lo = a.ph_lo, hi = a.ph_hi;
#ifndef PHMASK
#define PHMASK 0xFFFF
#endif
#define IN(k) (((PHMASK >> (k)) & 1) && lo <= (k) && (k) < hi)
    if (a.ph_hi > 4096) cg::this_grid().sync();
    volatile LAS unsigned* xb_st = (volatile LAS unsigned*)(ldsl + 139264);
    if (threadIdx.x < 4) xb_st[threadIdx.x] = 0u;
    __syncthreads();
    const XcdBarrier xbar = xcd_barrier_post((unsigned*)(ws + WS_BAR), xb_st);
#define SEAM(k) do { if (IN(k) && IN((k) + 1)) { xcd_barrier(xbar); } } while (0)

    if (IN(0)) for (int rep = 0; rep < NREP(0); ++rep) { if (rep) cg::this_grid().sync(); PHASE_IDS();
        LAS float* sc = (LAS float*)ldsl;
        LAS float* red = (LAS float*)(ldsl + 8192);
        const float* wada = a.in[I_WADA];
        typedef float f32x2_ __attribute__((ext_vector_type(2)));
        for (int it = bx; it < 96 * 8; it += G) {
            const int cc = it % 96, kc = it / 96;
            for (int idx = tid; idx < 1280; idx += NTHREADS) { const int cond = idx >> 8, kk = idx & 255;
                const float v = (cond < 4) ? a.in[I_C][cond * DM + kc * 256 + kk] : a.in[I_CCTX][kc * 256 + kk];
                sc[idx] = v / (1.0f + __expf(-v)); }
            __syncthreads();
            f32x2_ acc[5];
#pragma unroll
            for (int c5 = 0; c5 < 5; ++c5) acc[c5] = (f32x2_){0.f, 0.f};
            const float* wp = wada + (size_t)(kc * 256 + wave * 32) * ADAW + cc * 128 + lane * 2;
#pragma unroll 16
            for (int r = 0; r < 32; ++r) { const f32x2_ w2 = *(const f32x2_*)(wp + (size_t)r * ADAW);
#pragma unroll
                for (int c5 = 0; c5 < 5; ++c5) acc[c5] += sc[c5 * 256 + wave * 32 + r] * w2; }
#pragma unroll
            for (int c5 = 0; c5 < 5; ++c5) *(LAS f32x2_*)(red + (wave * 5 + c5) * 128 + lane * 2) = acc[c5];
            __syncthreads();
            for (int idx = tid; idx < 640; idx += NTHREADS) { const int cond = idx >> 7, col = idx & 127; float s = 0.f;
#pragma unroll
                for (int w = 0; w < 8; ++w) s += red[(w * 5 + cond) * 128 + col];
                MODP[(size_t)(kc * 5 + cond) * ADAW + cc * 128 + col] = s; }
            __syncthreads();
        }
        LAS float* scr = (LAS float*)(ldsl + wave * 16384);
        const int gw = vcu * NWAVES + wave, NGW = G * NWAVES;
        constexpr int I_1 = 32 * 320, I_2 = 32 * 64, I_3 = 16 * 64, I_4 = 32 * 64, I_5 = 32 * 176, I_6 = 32 * 176;
        constexpr int NITEMS = I_1 + I_2 + I_3 + I_4 + I_5 + I_6;
        for (int it = gw; it < NITEMS; it += NGW) {
            int r = it;
            if (r < I_1) { transpose_item(a.in[I_WIN], DM, INW, WinT, 3, scr, r, lane); continue; } r -= I_1;
            if (r < I_2) { transpose_item(a.in[I_WBRA], 2048, DM, WbrAT, 0, scr, r, lane); continue; } r -= I_2;
            if (r < I_3) { transpose_item(a.in[I_WBRB], 1024, DM, WbrBT, 0, scr, r, lane); continue; } r -= I_3;
            if (r < I_4) { transpose_item(a.in[I_WOUT], DM, DM, WoutT, 0, scr, r, lane); continue; } r -= I_4;
            if (r < I_5) { transpose_item(a.in[I_WFG], DM, DFF, WguT, 1, scr, r, lane); continue; } r -= I_5;
            transpose_item(a.in[I_WFU], DM, DFF, WguT, 2, scr, r, lane);
        }
        __syncthreads();
    }
    SEAM(0);

    if (IN(1)) for (int rep = 0; rep < NREP(1); ++rep) { if (rep) cg::this_grid().sync(); PHASE_IDS();
        LAS float* mA = (LAS float*)ldsl; LAS float* mS = mA + DM;
        const float* bada = a.in[I_BADA]; const float* g1 = a.in[I_N1G];
        for (int q = bx; q < 512; q += G) {
            const int cond = q < 256 ? (q >> 6) : 4;
            __syncthreads();
            for (int col = tid; col < DM; col += NTHREADS) { float sh = bada[col], scl = bada[DM + col];
#pragma unroll
                for (int kc = 0; kc < 8; ++kc) { sh += MODP[(size_t)(kc * 5 + cond) * ADAW + col]; scl += MODP[(size_t)(kc * 5 + cond) * ADAW + DM + col]; }
                mA[col] = g1[col] * (1.0f + scl); mS[col] = sh; }
            __syncthreads();
            if (q < 256) norm_chunk(a.in[I_X], Hb, q * 64, mA, mS, wave, lane);
            else if (wave < 4) norm_chunk(a.in[I_CTX], Hb + (size_t)MLAT * DM, (q - 256) * 4, mA, mS, wave, lane, 1);
        }
        for (int idx = bx * NTHREADS + tid; idx < 5 * ADAW; idx += G * NTHREADS) { const int cond = idx / ADAW, j = idx % ADAW; float v = bada[j];
#pragma unroll
            for (int kc = 0; kc < 8; ++kc) v += MODP[(size_t)(kc * 5 + cond) * ADAW + j];
            MOD[idx] = v; }
        __syncthreads();
    }
    SEAM(1);

    if (IN(2)) for (int rep = 0; rep < NREP(2); ++rep) { if (rep) cg::this_grid().sync(); PHASE_IDS();
        pg8::Gemm g{Hb, WinT, DM, DM, DM}; pg8::InprojOrder S; S.init(G, bx);
        pg8::EpiInproj E{KV, QG, a.in[I_KNA], a.in[I_KNB], a.in[I_QNA], a.in[I_QNB], (LAS float*)(ldsl + pg8::STAGE_BYTES)};
        pg8::gemm_phase<pg8::EpiInproj, pg8::InprojOrder>(ldsl, g, S, E);
    }
    SEAM(2);


    if (IN(4)) for (int rep = 0; rep < NREP(4); ++rep) { if (rep) cg::this_grid().sync(); PHASE_IDS();
        bool fastA;
        { float gmq = fmaxf(fabsf(a.in[I_QNA][lane]), fabsf(a.in[I_QNA][lane + 64])), gmk = fmaxf(fabsf(a.in[I_KNA][lane]), fabsf(a.in[I_KNA][lane + 64]));
#pragma unroll
          for (int o = 1; o < 64; o <<= 1) { gmq = fmaxf(gmq, __shfl_xor(gmq, o)); gmk = fmaxf(gmk, __shfl_xor(gmk, o)); }
          fastA = __uint_as_float(__builtin_amdgcn_readfirstlane(__float_as_uint((11.313708499f * 1.4426950408889634f * 1.02f) * gmq * gmk))) <= 60.f; }
#define ATT_A_LOOP(FASTV) for (int L = vcu; L < 1024; L += G) { \
            const int grp = L >> 6, rem = L & 63, b = grp >> 2, kvh = grp & 3, h = kvh * 4 + (rem >> 4), qb = rem & 15; \
            bf16_t* Qb = QG + (size_t)(b * SEQ + qb * 256) * QGW + h * 128; \
            const bf16_t* Kh = KV + (size_t)b * SKV * KVW + kvh * 128; const bf16_t* Vh = Kh + 512; \
            bf16_t* Ob = (NREP(4) == 2 && rep == 0) ? (bf16_t*)(ws + WS_WIN + 24 * MiB) : Qb; \
            if (FASTV) att::attn_unit_fast<128, QGW, QGW>(Qb, Kh, Vh, Ob, (char*)lds); else att::attn_unit<128, QGW, QGW, false, 1>(Qb, Kh, Vh, Ob, (char*)lds); }
#define ATT_B_FALLBACK() for (int L2 = vcu; L2 < 1024; L2 += G) { \
            const int grp = L2 >> 5, rem = L2 & 31, b = grp >> 3, h = grp & 7, sub = rem >> 4, qb = rem & 15; \
            const bf16_t* Qb = QG + (size_t)(b * SEQ + qb * 256) * QGW + 2048 + (h * 2 + sub) * 64; \
            const bf16_t* Kh = KV + (size_t)b * SKV * KVW + 1024 + (h * 2 + sub) * 64; const bf16_t* Vh = KV + (size_t)b * SKV * KVW + 2048 + h * 128; \
            bf16_t* Ob = OBraw + (size_t)(b * SEQ + qb * 256) * DM + (h * 2 + sub) * 128; \
            att::attn_unit<64, QGW, DM, false, 1>(Qb, Kh, Vh, Ob, (char*)lds); }
#define ATT_B_PAIRS() for (int L2 = vcu; L2 < 512; L2 += G) { \
            const int grp = L2 >> 4, b = grp >> 3, h = grp & 7, qb = L2 & 15; \
            const bf16_t* Qb = QG + (size_t)(b * SEQ + qb * 256) * QGW + 2048 + h * 128; \
            const bf16_t* Kh = KV + (size_t)b * SKV * KVW + 1024 + h * 128; const bf16_t* Vh = KV + (size_t)b * SKV * KVW + 2048 + h * 128; \
            att::attn_unit_fast<64, QGW, QGW>(Qb, Kh, Vh, nullptr, (char*)lds, 1); \
            att::attn_unit_fast<64, QGW, QGW>(Qb + 64, Kh + 64, Vh, QG + (size_t)(b * SEQ + qb * 256) * QGW + 2048 + h * 128, (char*)lds, 2, lam, a.in[I_SUBLN]); }
#define ATT_FENCE() do { asm volatile("" ::: "memory"); __builtin_amdgcn_sched_barrier(0); } while (0)
#ifndef ATT_X
#define ATT_X 15
#endif
        if (fastA) { if (ATT_X & 1) ATT_A_LOOP(true) } else { if (ATT_X & 2) ATT_A_LOOP(false) }
        ATT_FENCE();
        float lam; bool fastB;
        { int ln = threadIdx.x & 63; asm volatile("" : "+v"(ln));
          float g1_ = fabsf(a.in[I_QNB][ln]), g2_ = fabsf(a.in[I_KNB][ln]);
          float s1_ = a.in[I_LQ1][ln] * a.in[I_LK1][ln], s2_ = a.in[I_LQ2][ln] * a.in[I_LK2][ln];
#pragma unroll
          for (int o = 1; o < 64; o <<= 1) { g1_ = fmaxf(g1_, __shfl_xor(g1_, o)); g2_ = fmaxf(g2_, __shfl_xor(g2_, o)); s1_ += __shfl_xor(s1_, o); s2_ += __shfl_xor(s2_, o); }
          fastB = __uint_as_float(__builtin_amdgcn_readfirstlane(__float_as_uint((8.0f * 1.4426950408889634f * 1.02f) * g1_ * g2_))) <= 60.f;
          lam = __uint_as_float(__builtin_amdgcn_readfirstlane(__float_as_uint(expf(s1_) - expf(s2_) + 0.2f))); }
        if (fastB) { if (ATT_X & 4) ATT_B_PAIRS() } else { if (ATT_X & 8) ATT_B_FALLBACK() }
    }
    SEAM(4);
    bool p5_needed;
    { const int ln = threadIdx.x & 63; float g1_ = fabsf(a.in[I_QNB][ln]), g2_ = fabsf(a.in[I_KNB][ln]);
#pragma unroll
      for (int o = 1; o < 64; o <<= 1) { g1_ = fmaxf(g1_, __shfl_xor(g1_, o)); g2_ = fmaxf(g2_, __shfl_xor(g2_, o)); }
      p5_needed = !(__uint_as_float(__builtin_amdgcn_readfirstlane(__float_as_uint((8.0f * 1.4426950408889634f * 1.02f) * g1_ * g2_))) <= 60.f); }

    if (IN(5) && p5_needed) for (int rep = 0; rep < NREP(5); ++rep) { if (rep) cg::this_grid().sync(); PHASE_IDS();
        const int gw = vcu * NWAVES + wave, NGW = G * NWAVES;
        const float s1 = wave_sum(a.in[I_LQ1][lane] * a.in[I_LK1][lane]), s2 = wave_sum(a.in[I_LQ2][lane] * a.in[I_LK2][lane]);
        const float lam_init = 0.2f, lam = expf(s1) - expf(s2) + lam_init;
        const int h = lane >> 3, e0 = (lane & 7) * 16; const float* sg = a.in[I_SUBLN];
        float gg[16];
#pragma unroll
        for (int e = 0; e < 16; ++e) gg[e] = sg[e0 + e] * (1.0f - lam_init);
        for (int t = gw; t < MLAT; t += NGW) {
            const bf16_t* src = OBraw + (size_t)t * DM + (h * 2) * 128 + e0;
            const u32x4 a0 = *(const u32x4*)src, a1 = *(const u32x4*)(src + 8), b0 = *(const u32x4*)(src + 128), b1 = *(const u32x4*)(src + 136);
            float x0[16], x1[16]; unpack8(a0, x0); unpack8(a1, x0 + 8); unpack8(b0, x1); unpack8(b1, x1 + 8);
            float d[16]; float ss = 0.f;
#pragma unroll
            for (int e = 0; e < 16; ++e) { d[e] = x0[e] - lam * x1[e]; ss += d[e] * d[e]; }
            ss += __shfl_xor(ss, 1); ss += __shfl_xor(ss, 2); ss += __shfl_xor(ss, 4);
            const float rstd = rsqrtf(ss * (1.0f / 128) + EPS);
#pragma unroll
            for (int e = 0; e < 16; ++e) d[e] = d[e] * rstd * gg[e];
            bf16_t* dst = QG + (size_t)t * QGW + 2048 + h * 128 + e0;
            *(u32x4*)dst = pack8(d); *(u32x4*)(dst + 8) = pack8(d + 8);
        }
    }
    if (p5_needed) SEAM(5);

    if (IN(6)) for (int rep = 0; rep < NREP(6); ++rep) { if (rep) cg::this_grid().sync(); PHASE_IDS();
        {
            const int gw = vcu * NWAVES + wave, NGW = G * NWAVES; LAS float* scr = (LAS float*)(ldsl + wave * 16384);
            for (int it = gw; it < 88 * 64; it += NGW) transpose_item(a.in[I_WFD], DFF, DM, WdT, 0, scr, it, lane);
            __syncthreads(); }
        { pg8::Gemm g{QG, WbrAT, 2048, QGW, 2048}; pg8::StaticOrder S; S.init(MLAT, DM, G, bx);
          pg8::EpiBranch<0> E{Tm, QG, 3072};
          pg8::gemm_phase<pg8::EpiBranch<0>, pg8::StaticOrder>(ldsl, g, S, E); }
        { pg8::Gemm g{QG + 2048, WbrBT, 1024, QGW, 1024}; pg8::StaticOrder S; S.init(MLAT, DM, G, bx);
          pg8::EpiBranch<1> E{Tm, QG, 5120};
          pg8::gemm_phase<pg8::EpiBranch<1>, pg8::StaticOrder>(ldsl, g, S, E); }
    }
    SEAM(6);

    if (IN(7)) for (int rep = 0; rep < NREP(7); ++rep) { if (rep) cg::this_grid().sync(); PHASE_IDS();
        pg8::Gemm g{Tm, WoutT, DM, DM, DM}; pg8::StaticOrder S; S.init(MLAT, DM, G, bx);
        pg8::EpiResid E{a.in[I_X], a.out, MOD + 2 * DM};
        pg8::gemm_phase<pg8::EpiResid, pg8::StaticOrder>(ldsl, g, S, E);
    }
    SEAM(7);

    if (IN(8)) for (int rep = 0; rep < NREP(8); ++rep) { if (rep) cg::this_grid().sync(); PHASE_IDS();
        LAS float* mA = (LAS float*)ldsl; LAS float* mS = mA + DM; const float* g2 = a.in[I_N2G];
        for (int q = bx; q < 256; q += G) {
            const int cond = q >> 6;
            __syncthreads();
            for (int col = tid; col < DM; col += NTHREADS) { mA[col] = g2[col] * (1.0f + MOD[(size_t)cond * ADAW + 4 * DM + col]); mS[col] = MOD[(size_t)cond * ADAW + 3 * DM + col]; }
            __syncthreads();
            norm_chunk(a.out, H2, q * 64, mA, mS, wave, lane);
        }
        __syncthreads();
    }
    SEAM(8);

    if (IN(9)) for (int rep = 0; rep < NREP(9); ++rep) { if (rep) cg::this_grid().sync(); PHASE_IDS();
        pg8::Gemm g{H2, WguT, DM, DM, DM}; pg8::StaticOrder S; S.init(MLAT, 2 * DFF, G, bx);
        pg8::EpiSwiglu E{HM};
        pg8::gemm_phase<pg8::EpiSwiglu, pg8::StaticOrder>(ldsl, g, S, E);
    }
    SEAM(9);

    if (IN(10)) for (int rep = 0; rep < NREP(10); ++rep) { if (rep) cg::this_grid().sync(); PHASE_IDS();
        pg8::Gemm g{HM, WdT, DFF, DFF, DFF}; pg8::StaticOrder S; S.init(MLAT, DM, G, bx);
        pg8::EpiResid E{a.out, a.out, MOD + 5 * DM};
        pg8::gemm_phase<pg8::EpiResid, pg8::StaticOrder>(ldsl, g, S, E);
    }
    if (REPMASK & 2048) { for (int i = 0; i < 10; ++i) cg::this_grid().sync(); }
#undef IN
#undef SEAM
}

extern "C" void kernel_launch(void* const* d_in, const int* in_sizes, int n_in, void* d_out, int out_size, void* d_ws, size_t ws_size, hipStream_t stream) {
    static int grid = 0;
    if (grid == 0) {
        if (n_in != 24 || in_sizes[0] != MLAT * DM || out_size != MLAT * DM || ws_size < WS_END) {
            fprintf(stderr, "kernel_launch: unexpected shapes (n_in %d, in0 %d, out %d, ws %zu)\n", n_in, n_in > 0 ? in_sizes[0] : -1, out_size, ws_size); grid = -1; return; }
        int dev = 0, cus = 0, per_cu = 0;
        if (hipGetDevice(&dev) != hipSuccess || hipDeviceGetAttribute(&cus, hipDeviceAttributeMultiprocessorCount, dev) != hipSuccess) { grid = -1; return; }
        if (hipFuncSetAttribute((const void*)fwd_kernel, hipFuncAttributeMaxDynamicSharedMemorySize, LDS_BYTES) != hipSuccess) { fprintf(stderr, "kernel_launch: hipFuncSetAttribute failed\n"); grid = -1; return; }
        if (hipOccupancyMaxActiveBlocksPerMultiprocessor(&per_cu, (const void*)fwd_kernel, NTHREADS, LDS_BYTES) != hipSuccess || per_cu < 1) { fprintf(stderr, "kernel_launch: occupancy query failed (%d)\n", per_cu); per_cu = 1; }
        (void)hipGetLastError();
        grid = cus * per_cu;
        if (grid > 256) grid = 256;
    }
    if (grid < 0) return;
    Args a{};
    for (int i = 0; i < 24; ++i) a.in[i] = (const float*)d_in[i];
    a.out = (float*)d_out; a.ws = (unsigned char*)d_ws;
#if MK_SINGLE
    (void)hipMemsetAsync((char*)d_ws + WS_BAR, 0, XCD_BAR_WORDS * 4, stream);
    a.ph_lo = 0; a.ph_hi = NPHASES;
    void* args[] = {&a};
    hipError_t e = hipLaunchCooperativeKernel((void*)fwd_kernel, dim3(grid), dim3(NTHREADS), args, LDS_BYTES, stream);
    if (e != hipSuccess) fprintf(stderr, "cooperative launch failed: %s (grid %d)\n", hipGetErrorString(e), grid);
#else
    for (int p = 0; p < NPHASES; ++p) {
        a.ph_lo = p; a.ph_hi = p + 1;
        hipLaunchKernelGGL(fwd_kernel, dim3(grid), dim3(NTHREADS), LDS_BYTES, stream, a);
    }
#endif
}
```

```cpp
#include <hip/hip_runtime.h>
#include <hip/hip_bf16.h>
#include <hip/hip_cooperative_groups.h>
#include <cstdio>
#include <cstdint>
namespace cg = cooperative_groups;

#ifndef MK_SINGLE
#define MK_SINGLE 1
#endif

#ifndef REPMASK
#define REPMASK 0
#endif
#define NREP(k) (1 + ((REPMASK >> (k)) & 1))
#define LAS __attribute__((address_space(3)))
typedef unsigned short bf16_t;
typedef short bf16x8 __attribute__((ext_vector_type(8)));
typedef short s16x4 __attribute__((ext_vector_type(4)));
typedef float f32x4 __attribute__((ext_vector_type(4)));
typedef float f32x16 __attribute__((ext_vector_type(16)));
typedef unsigned u32x4 __attribute__((ext_vector_type(4)));
typedef unsigned u32x2 __attribute__((ext_vector_type(2)));

constexpr int DM = 2048, NBATCH = 4, SEQ = 4096, CTXL = 256, SKV = SEQ + CTXL;
constexpr int MLAT = NBATCH * SEQ, MCTX = NBATCH * CTXL, MALL = MLAT + MCTX;
constexpr int KVW = 3072, INW = 10240, QGW = 7168, DFF = 5632, ADAW = 12288;
constexpr float EPS = 1e-6f;
constexpr float QSC_A = 0.088388347648318440f * 1.4426950408889634f, QSC_B = 0.125f * 1.4426950408889634f;
constexpr int NTHREADS = 512, NWAVES = 8;
constexpr int LDS_BYTES = 143360;

constexpr size_t MiB = 1u << 20;
constexpr size_t WS_MODP = 0;
constexpr size_t WS_MOD = 2 * MiB;
constexpr size_t WS_BAR = 3 * MiB;
constexpr size_t WS_WIN = 4 * MiB;
constexpr size_t WS_WD = 4 * MiB;
constexpr size_t WS_WBRA = 44 * MiB;
constexpr size_t WS_WBRB = 52 * MiB;
constexpr size_t WS_WOUT = 56 * MiB;
constexpr size_t WS_WGU = 64 * MiB;
constexpr size_t WS_H = 108 * MiB;
constexpr size_t WS_KV = 176 * MiB;
constexpr size_t WS_QG = 278 * MiB;
constexpr size_t WS_END = 502 * MiB;

__device__ __forceinline__ unsigned cvt_pk_bf16(float lo, float hi) { unsigned r; asm volatile("v_cvt_pk_bf16_f32 %0, %1, %2" : "=v"(r) : "v"(lo), "v"(hi)); return r; }
__device__ __forceinline__ float bf_lo(unsigned w) { return __uint_as_float(w << 16); }
__device__ __forceinline__ float bf_hi(unsigned w) { return __uint_as_float(w & 0xffff0000u); }
__device__ __forceinline__ float wave_sum(float v) {
#pragma unroll
    for (int o = 1; o < 64; o <<= 1) v += __shfl_xor(v, o);
    return v;
}
__device__ __forceinline__ float sigmoidf_(float x) { return __builtin_amdgcn_rcpf(1.0f + __builtin_amdgcn_exp2f(-1.4426950408889634f * x)); }
__device__ __forceinline__ void unpack8(u32x4 w, float* x) {
    x[0] = bf_lo(w.x); x[1] = bf_hi(w.x); x[2] = bf_lo(w.y); x[3] = bf_hi(w.y); x[4] = bf_lo(w.z); x[5] = bf_hi(w.z); x[6] = bf_lo(w.w); x[7] = bf_hi(w.w);
}
__device__ __forceinline__ u32x4 pack8(const float* x) {
    u32x4 w; w.x = cvt_pk_bf16(x[0], x[1]); w.y = cvt_pk_bf16(x[2], x[3]); w.z = cvt_pk_bf16(x[4], x[5]); w.w = cvt_pk_bf16(x[6], x[7]); return w;
}

namespace pg8 {
constexpr int BM = 256, BK = 64, HALF = 128, HTB = HALF * BK * 2, STAGE_BYTES = 8 * HTB, NXCD = 8, WGM = 8;
__host__ __device__ __forceinline__ int lds_byte(int r, int c) { const int st = (r >> 4) * 2 + (c >> 5), rr = r & 15, cc = c & 31, ob = rr * 64 + cc * 2; return st * 1024 + (ob ^ (((ob >> 9) & 1) << 5)); }
__host__ __device__ __forceinline__ void stage_rc(int b, int& R, int& C) { const int st = b / 1024, sb = b % 1024, swz = sb ^ (((sb >> 9) & 1) << 5); R = (st >> 1) * 16 + swz / 64; C = (st & 1) * 32 + (swz % 64) / 2; }
__host__ __device__ __forceinline__ int perm32(int rho) { const int n = rho >> 4, i = rho & 15; return 8 * (i >> 2) + 4 * n + (i & 3); }

struct Unit { int pm, pn; };
struct Gemm { const bf16_t* A; const bf16_t* Bt; int K, lda, ldb; };

struct StaticOrder {
    int nM, nN, nwg, G, c;
    __device__ void init(int M, int N, int G_, int c_) { nM = M / BM; nN = N / BM; nwg = nM * nN; G = G_; c = c_; }
    __device__ bool map(long L, Unit& u) const {
        if (L >= nwg) return false;
        int wgid = (int)L; { const int q = nwg / NXCD, r = nwg % NXCD, xcd = wgid % NXCD, off = wgid / NXCD; wgid = (xcd < r ? xcd * (q + 1) : r * (q + 1) + (xcd - r) * q) + off; }
        const int nig = WGM * nN, gid = wgid / nig, fm = gid * WGM, gsz = (nM - fm) < WGM ? (nM - fm) : WGM;
        u.pm = fm + ((wgid % nig) % gsz); u.pn = (wgid % nig) / gsz; return true;
    }
    __device__ bool next(int i, Unit& u) const { return map((long)i * G + c, u); }
};
struct InprojOrder {
    StaticOrder so;
    __device__ void init(int G_, int c_) { so.init(MLAT, INW, G_, c_); }
    __device__ bool next(int i, Unit& u) const {
        const long L = (long)i * so.G + so.c;
        if (L < so.nwg) return so.map(L, u);
        const int L2 = (int)(L - so.nwg); if (L2 >= 48) return false;
        u.pm = 64 + L2 / 12; u.pn = L2 % 12; return true;
    }
};

template <class Epi, class Sched>
__device__ __forceinline__ void gemm_phase(LAS unsigned char* lds, const Gemm g, const Sched& S, const Epi& E) {
    const int tid = threadIdx.x, wid = __builtin_amdgcn_readfirstlane(tid >> 6), lane = tid & 63, wr = wid >> 2, wc = wid & 3, fr = lane & 15, fq = lane >> 4;
    const int nt = g.K / BK;
    unsigned voffA[2], voffB[2];
#pragma unroll
    for (int i = 0; i < 2; ++i) { int R, C; stage_rc(tid * 16 + i * 8192, R, C); const int Rb = (R & ~31) + perm32(R & 31);
        voffA[i] = (unsigned)(R * g.lda + C) * 2u; voffB[i] = (unsigned)(Rb * g.ldb + C) * 2u; }
    const size_t kstep = (size_t)(BK * 2);
    const size_t hA = (size_t)HALF * g.lda * 2, hB = (size_t)HALF * g.ldb * 2, tA = 2 * hA, tB = 2 * hB;
    const unsigned ldsw = (unsigned)wid * 1024u;
    const int aoff = lds_byte(wr * 64 + fr, fq * 8), boff = lds_byte(wc * 32 + fr, fq * 8);
#define PG8_SA(b, h) (((b) * 2 + (h)) * HTB)
#define PG8_SB(b, h) ((4 + (b) * 2 + (h)) * HTB)
#define PG8_STAGE(bufoff, gbase, voff) do { _Pragma("unroll") for (int _i = 0; _i < 2; ++_i) \
        __builtin_amdgcn_global_load_lds((const unsigned*)((const char*)(gbase) + (voff)[_i]), (LAS unsigned*)(lds + (bufoff) + ldsw + _i * 8192), 16, 0, 0); } while (0)
#define PG8_LDA(dst, b, h) do { _Pragma("unroll") for (int m = 0; m < 4; ++m) _Pragma("unroll") for (int k = 0; k < 2; ++k) dst[m][k] = *(const LAS bf16x8*)(lds + PG8_SA(b, h) + aoff + m * 2048 + k * 1024); } while (0)
#define PG8_LDB(dst, b, h) do { _Pragma("unroll") for (int n = 0; n < 2; ++n) _Pragma("unroll") for (int k = 0; k < 2; ++k) dst[n][k] = *(const LAS bf16x8*)(lds + PG8_SB(b, h) + boff + n * 2048 + k * 1024); } while (0)
#define PG8_MMA(ai, bj, At, Bt) do { __builtin_amdgcn_s_setprio(1); _Pragma("unroll") for (int m = 0; m < 4; ++m) _Pragma("unroll") for (int n = 0; n < 2; ++n) _Pragma("unroll") for (int k = 0; k < 2; ++k) \
        acc[ai][bj][m][n] = __builtin_amdgcn_mfma_f32_16x16x32_bf16(Bt[n][k], At[m][k], acc[ai][bj][m][n], 0, 0, 0); __builtin_amdgcn_s_setprio(0); } while (0)
#define PG8_WAIT_V(n) asm volatile("s_waitcnt vmcnt(" #n ")" ::: "memory")
#define PG8_WAIT_L(n) asm volatile("s_waitcnt lgkmcnt(" #n ")" ::: "memory")
#define PG8_BAR __builtin_amdgcn_s_barrier()
#define PG8_SCHED __builtin_amdgcn_sched_barrier(0)
    Unit cur, nxt; int ui = 0;
    if (!S.next(0, cur)) return;
    f32x4 acc[2][2][4][2];
#pragma unroll
    for (int a = 0; a < 2; ++a)
#pragma unroll
        for (int b = 0; b < 2; ++b)
#pragma unroll
            for (int m = 0; m < 4; ++m)
#pragma unroll
                for (int n = 0; n < 2; ++n) acc[a][b][m][n] = (f32x4){0.f, 0.f, 0.f, 0.f};
    bf16x8 At[4][2], B0[2][2], B1[2][2];
    const char* cA = (const char*)g.A + (size_t)cur.pm * tA; const char* cB = (const char*)g.Bt + (size_t)cur.pn * tB;
    PG8_STAGE(PG8_SB(0, 0), cB, voffB); PG8_STAGE(PG8_SB(0, 1), cB + hB, voffB); PG8_STAGE(PG8_SA(0, 0), cA, voffA); PG8_STAGE(PG8_SA(0, 1), cA + hA, voffA);
    if (wr == 1) PG8_BAR;
    PG8_WAIT_V(2); PG8_BAR;
    PG8_STAGE(PG8_SB(1, 0), cB + kstep, voffB); PG8_STAGE(PG8_SA(1, 0), cA + kstep, voffA); PG8_STAGE(PG8_SB(1, 1), cB + hB + kstep, voffB);
    PG8_WAIT_V(6); PG8_BAR;
    for (;;) {
        const bool has_next = S.next(ui + 1, nxt);
        const char* nA = has_next ? (const char*)g.A + (size_t)nxt.pm * tA : cA; const char* nB = has_next ? (const char*)g.Bt + (size_t)nxt.pn * tB : cB;
        for (int t = 0; t < nt; t += 2) {
            const bool last = (t == nt - 2);
            const char* a1 = cA + (size_t)(t + 1) * kstep;
            const char* a2 = last ? nA : cA + (size_t)(t + 2) * kstep; const char* b2 = last ? nB : cB + (size_t)(t + 2) * kstep;
            const char* a3 = a2 + kstep; const char* b3 = b2 + kstep;
            PG8_LDB(B0, 0, 0); PG8_LDB(B1, 0, 1); PG8_SCHED; PG8_LDA(At, 0, 0); PG8_STAGE(PG8_SA(1, 1), a1 + hA, voffA);
            PG8_WAIT_V(8); PG8_WAIT_L(0); PG8_BAR; PG8_MMA(0, 0, At, B0); PG8_MMA(0, 1, At, B1); PG8_BAR; PG8_SCHED;
            PG8_LDA(At, 0, 1); PG8_STAGE(PG8_SB(0, 0), b2, voffB); PG8_STAGE(PG8_SB(0, 1), b2 + hB, voffB); PG8_STAGE(PG8_SA(0, 0), a2, voffA);
            PG8_WAIT_V(8); PG8_WAIT_L(0); PG8_BAR; PG8_MMA(1, 0, At, B0); PG8_MMA(1, 1, At, B1); PG8_BAR; PG8_SCHED;
            PG8_LDB(B0, 1, 0); PG8_LDB(B1, 1, 1); PG8_SCHED; PG8_LDA(At, 1, 0); PG8_STAGE(PG8_SA(0, 1), a2 + hA, voffA);
            PG8_WAIT_V(8); PG8_WAIT_L(0); PG8_BAR; PG8_MMA(0, 0, At, B0); PG8_MMA(0, 1, At, B1); PG8_BAR; PG8_SCHED;
            PG8_LDA(At, 1, 1); PG8_STAGE(PG8_SB(1, 0), b3, voffB); PG8_STAGE(PG8_SB(1, 1), b3 + hB, voffB); PG8_STAGE(PG8_SA(1, 0), a3, voffA);
            PG8_WAIT_V(8); PG8_WAIT_L(0); PG8_BAR; PG8_MMA(1, 0, At, B0); PG8_MMA(1, 1, At, B1); PG8_BAR; PG8_SCHED;
        }
        if (wr == 0) PG8_BAR;
        E(acc, cur, wr, wc, fr, fq);
        if (!has_next) break;
#pragma unroll
        for (int a = 0; a < 2; ++a)
#pragma unroll
            for (int b = 0; b < 2; ++b)
#pragma unroll
                for (int m = 0; m < 4; ++m)
#pragma unroll
                    for (int n = 0; n < 2; ++n) acc[a][b][m][n] = (f32x4){0.f, 0.f, 0.f, 0.f};
        cur = nxt; cA = nA; cB = nB; ++ui;
        if (wr == 1) PG8_BAR;
    }
    PG8_WAIT_V(0);
    PG8_BAR;
#undef PG8_SA
#undef PG8_SB
#undef PG8_STAGE
#undef PG8_LDA
#undef PG8_LDB
#undef PG8_MMA
#undef PG8_WAIT_V
#undef PG8_WAIT_L
#undef PG8_BAR
#undef PG8_SCHED
}

typedef f32x4 Acc[2][2][4][2];
#define EPI_FENCE() asm volatile("" ::: "memory")

struct EpiInproj {
    bf16_t* KV; bf16_t* QG; const float* gka; const float* gkb; const float* gqa; const float* gqb; LAS float* X;
    __device__ __forceinline__ void operator()(const Acc& acc, const Unit& u, int wr, int wc, int fr_, int fq_) const {
        int fr = fr_, fq = fq_; asm volatile("" : "+v"(fr), "+v"(fq));
        bf16_t* base; size_t ld; int rowbase, colt; bool sig = false; int hk = 0; const float* g = nullptr; float osc = 1.f;
        if (u.pn < 12) { base = KV; ld = KVW; colt = u.pn * BM;
            if (u.pm < 64) rowbase = (u.pm >> 4) * SKV + CTXL + (u.pm & 15) * BM; else rowbase = (u.pm - 64) * SKV;
            if (u.pn < 2) { hk = 1; g = gka; } else if (u.pn >= 4 && u.pn < 8) { hk = 2; g = gkb; } }
        else { base = QG; ld = QGW; colt = (u.pn - 12) * BM; rowbase = u.pm * BM; sig = u.pn >= 24;
            if (u.pn < 20) { hk = 1; g = gqa; osc = QSC_A; } else if (u.pn < 24) { hk = 2; g = gqb; osc = QSC_B; } }
        const int row0 = rowbase + wr * 64 + fr, col0 = colt + wc * 32 + 8 * fq;
        if (hk == 0) {
#pragma unroll
            for (int ai = 0; ai < 2; ++ai)
#pragma unroll
                for (int m = 0; m < 4; ++m) { bf16_t* rowp = base + (size_t)(row0 + ai * HALF + m * 16) * ld + col0;
#pragma unroll
                    for (int bj = 0; bj < 2; ++bj) { f32x4 v0 = acc[ai][bj][m][0], v1 = acc[ai][bj][m][1];
                        if (sig) {
#pragma unroll
                            for (int j = 0; j < 4; ++j) { v0[j] = sigmoidf_(v0[j]); v1[j] = sigmoidf_(v1[j]); } }
                        u32x4 w; w.x = cvt_pk_bf16(v0[0], v0[1]); w.y = cvt_pk_bf16(v0[2], v0[3]); w.z = cvt_pk_bf16(v1[0], v1[1]); w.w = cvt_pk_bf16(v1[2], v1[3]);
                        *(u32x4*)(rowp + bj * HALF) = w; } }
            return;
        }
#pragma unroll
        for (int ai = 0; ai < 2; ++ai)
#pragma unroll
            for (int m = 0; m < 4; ++m)
#pragma unroll
                for (int bj = 0; bj < 2; ++bj) { const f32x4 v0 = acc[ai][bj][m][0], v1 = acc[ai][bj][m][1];
                    float sq = (v0[0] * v0[0] + v0[1] * v0[1]) + (v0[2] * v0[2] + v0[3] * v0[3]) + (v1[0] * v1[0] + v1[1] * v1[1]) + (v1[2] * v1[2] + v1[3] * v1[3]);
                    sq += __shfl_xor(sq, 16); sq += __shfl_xor(sq, 32);
                    if (fq == 0) X[((ai * HALF + wr * 64 + m * 16 + fr) * 2 + bj) * 4 + wc] = sq; }
        asm volatile("s_waitcnt lgkmcnt(0)" ::: "memory"); __builtin_amdgcn_s_barrier(); asm volatile("" ::: "memory");
        const bool h128 = (hk == 1), rope = u.pm < 64;
        const int t0 = h128 ? (16 * wc + 4 * fq) : (16 * (wc & 1) + 4 * fq);
        const int hd2 = h128 ? 64 : 32, nf = h128 ? 32 : 16;
        const bool userow = t0 < nf; const float inv_w = h128 ? (1.0f / 128) : (1.0f / 64);
#pragma unroll
        for (int ai = 0; ai < 2; ++ai)
#pragma unroll
            for (int m = 0; m < 4; ++m) { const int rt = ai * HALF + wr * 64 + m * 16 + fr;
                const int sp = (u.pm & 15) * BM + rt; const float pos = userow ? (float)(sp >> 6) : (float)(sp & 63);
                float cs[4], sn[4], ga[4], gb[4];
                { const float* gp = g + t0; asm volatile("" : "+v"(gp));
                  const f32x4 g1 = *(const f32x4*)gp, g2 = *(const f32x4*)(gp + hd2);
#pragma unroll
                  for (int p = 0; p < 4; ++p) { ga[p] = g1[p] * osc; gb[p] = g2[p] * osc; } }
#pragma unroll
                for (int p = 0; p < 4; ++p) { const float ang = pos * __builtin_amdgcn_exp2f(-(float)((t0 + p) & (nf - 1)) * (13.287712379549449f / (float)nf));
                    cs[p] = rope ? __cosf(ang) : 1.f; sn[p] = rope ? __sinf(ang) : 0.f; }
                bf16_t* rowp = base + (size_t)(rowbase + rt) * ld + col0;
#pragma unroll
                for (int bj = 0; bj < 2; ++bj) { const f32x4 xs = *(const LAS f32x4*)(X + (rt * 2 + bj) * 4);
                    const float tot = h128 ? ((xs[0] + xs[1]) + (xs[2] + xs[3])) : ((wc & 2) ? (xs[2] + xs[3]) : (xs[0] + xs[1]));
                    const float rstd = rsqrtf(tot * inv_w + EPS);
                    const f32x4 v0 = acc[ai][bj][m][0], v1 = acc[ai][bj][m][1];
                    float o[8]; const float e[8] = {v0[0], v0[1], v0[2], v0[3], v1[0], v1[1], v1[2], v1[3]};
#pragma unroll
                    for (int p = 0; p < 4; ++p) { const float x1 = e[2 * p] * rstd * ga[p], x2 = e[2 * p + 1] * rstd * gb[p];
                        o[2 * p] = x1 * cs[p] - x2 * sn[p]; o[2 * p + 1] = x2 * cs[p] + x1 * sn[p]; }
                    *(u32x4*)(rowp + bj * HALF) = pack8(o); }
                EPI_FENCE(); __builtin_amdgcn_sched_barrier(0); }
    }
};
template <int MODE> struct EpiBranch {
    bf16_t* T; const bf16_t* QG; int gcol0;
    __device__ __forceinline__ void operator()(const Acc& acc, const Unit& u, int wr, int wc, int fr, int fq) const {
        const int row0 = u.pm * BM + wr * 64 + fr, col0 = u.pn * BM + wc * 32 + 8 * fq;
#pragma unroll
        for (int ai = 0; ai < 2; ++ai)
#pragma unroll
            for (int m = 0; m < 4; ++m) { const int row = row0 + ai * HALF + m * 16;
#pragma unroll
                for (int bj = 0; bj < 2; ++bj) {
                    const u32x4 gw = *(const u32x4*)(QG + (size_t)row * QGW + gcol0 + col0 + bj * HALF);
                    float gt[8]; unpack8(gw, gt);
                    bf16_t* tp = T + (size_t)row * DM + col0 + bj * HALF;
                    float o[8];
                    const f32x4 v0 = acc[ai][bj][m][0], v1 = acc[ai][bj][m][1];
#pragma unroll
                    for (int j = 0; j < 4; ++j) { o[j] = gt[j] * v0[j]; o[4 + j] = gt[4 + j] * v1[j]; }
                    if (MODE == 1) { const u32x4 tw = *(const u32x4*)tp; float tv[8]; unpack8(tw, tv);
#pragma unroll
                        for (int j = 0; j < 8; ++j) o[j] += tv[j]; }
                    *(u32x4*)tp = pack8(o); }
                EPI_FENCE(); }
    }
};
struct EpiResid {
    const float* base; float* out; const float* gate;
    __device__ __forceinline__ void operator()(const Acc& acc, const Unit& u, int wr, int wc, int fr, int fq) const {
        const int row0 = u.pm * BM + wr * 64 + fr, col0 = u.pn * BM + wc * 32 + 8 * fq;
        const float* gp = gate + (size_t)(u.pm >> 4) * ADAW + col0;
        f32x4 gv[2][2];
#pragma unroll
        for (int bj = 0; bj < 2; ++bj) { gv[bj][0] = *(const f32x4*)(gp + bj * HALF); gv[bj][1] = *(const f32x4*)(gp + bj * HALF + 4); }
#pragma unroll
        for (int ai = 0; ai < 2; ++ai)
#pragma unroll
            for (int m = 0; m < 4; ++m) { const size_t off = (size_t)(row0 + ai * HALF + m * 16) * DM + col0;
#pragma unroll
                for (int bj = 0; bj < 2; ++bj) {
                    const f32x4 b0 = *(const f32x4*)(base + off + bj * HALF), b1 = *(const f32x4*)(base + off + bj * HALF + 4);
                    *(f32x4*)(out + off + bj * HALF) = b0 + gv[bj][0] * acc[ai][bj][m][0];
                    *(f32x4*)(out + off + bj * HALF + 4) = b1 + gv[bj][1] * acc[ai][bj][m][1]; }
                EPI_FENCE(); }
    }
};
struct EpiSwiglu {
    bf16_t* HM;
    __device__ __forceinline__ void operator()(const Acc& acc, const Unit& u, int wr, int wc, int fr, int fq) const {
        const int row0 = u.pm * BM + wr * 64 + fr, col0 = u.pn * HALF + wc * 32 + 8 * fq;
#pragma unroll
        for (int ai = 0; ai < 2; ++ai)
#pragma unroll
            for (int m = 0; m < 4; ++m) { float o[8];
#pragma unroll
                for (int n = 0; n < 2; ++n)
#pragma unroll
                    for (int j = 0; j < 4; ++j) { const float gg = acc[ai][0][m][n][j], uu = acc[ai][1][m][n][j]; o[4 * n + j] = gg * sigmoidf_(gg) * uu; }
                *(u32x4*)(HM + (size_t)(row0 + ai * HALF + m * 16) * DFF + col0) = pack8(o); }
    }
};
}

namespace att {
constexpr int NW = 8, QBLK = 32, KVBLK = 64, DV = 128, LDK = KVW;
constexpr int SHM_V = KVBLK * DV * 2;
constexpr int OFF_K = 2 * SHM_V, OFF_WS = 65536, OFF_Q = OFF_WS + 2048;
constexpr float THR = 8.f;
#define SBAR() __builtin_amdgcn_sched_barrier(0)
__device__ __forceinline__ int crow(int r, int hi) { return (r & 3) + 8 * (r >> 2) + 4 * hi; }
template <int DQK> __device__ __forceinline__ int kswz(int row, int colB) {
    if (DQK == 128) return row * 256 + (colB ^ ((row & 15) << 4));
    else return row * 128 + (colB ^ (((row >> 1) & 7) << 4));
}
template <bool FAST> __device__ __forceinline__ void partialSM(f32x16& p0, f32x16& p1, float& m_reg, float& mn, float& alpha) {
    if (!FAST) {
        constexpr float THR2 = THR * 1.4426950408889634f;
        float pmax = p0[0];
#pragma unroll
        for (int r = 1; r < 16; ++r) pmax = fmaxf(pmax, p0[r]);
#pragma unroll
        for (int r = 0; r < 16; ++r) pmax = fmaxf(pmax, p1[r]);
        { auto rr = __builtin_amdgcn_permlane32_swap(__float_as_uint(pmax), __float_as_uint(pmax), false, false);
          pmax = fmaxf(__uint_as_float(rr[0]), __uint_as_float(rr[1])); }
        if (__builtin_expect(__all(pmax - m_reg <= THR2), 1)) { mn = m_reg; alpha = 1.f; }
        else { mn = fmaxf(m_reg, pmax); alpha = __builtin_amdgcn_exp2f(m_reg - mn); m_reg = mn; }
#pragma unroll
        for (int r = 0; r < 16; ++r) p0[r] = p0[r] - mn;
#pragma unroll
        for (int r = 0; r < 16; ++r) p1[r] = p1[r] - mn;
    }
    if (FAST) SBAR();
#pragma unroll
    for (int r = 0; r < 16; ++r) p0[r] = __builtin_amdgcn_exp2f(p0[r]);
    if (FAST) SBAR();
}
template <bool FAST> __device__ __forceinline__ void finishSM(f32x16& p0, f32x16& p1, float alpha, float& l_reg, bf16x8& pa0, bf16x8& pa1, bf16x8& pa2, bf16x8& pa3) {
    if (FAST) SBAR();
#pragma unroll
    for (int r = 0; r < 16; ++r) p1[r] = __builtin_amdgcn_exp2f(p1[r]);
    float ps = 0;
    if (FAST) { float s0 = 0.f, s1 = 0.f, s2 = 0.f, s3 = 0.f;
#pragma unroll
        for (int r = 0; r < 16; r += 4) { s0 += p0[r] + p1[r]; s1 += p0[r + 1] + p1[r + 1]; s2 += p0[r + 2] + p1[r + 2]; s3 += p0[r + 3] + p1[r + 3]; }
        ps = (s0 + s1) + (s2 + s3); }
    else {
#pragma unroll
    for (int r = 0; r < 16; ++r) ps += p0[r];
#pragma unroll
    for (int r = 0; r < 16; ++r) ps += p1[r];
    }
    if (FAST) { SBAR(); l_reg += ps; }
    else { auto rr = __builtin_amdgcn_permlane32_swap(__float_as_uint(ps), __float_as_uint(ps), false, false);
           ps = __uint_as_float(rr[0]) + __uint_as_float(rr[1]); l_reg = l_reg * alpha + ps; }
#define PK4(P, BASE, OUT) do { unsigned a0 = cvt_pk_bf16(P[BASE + 0], P[BASE + 1]), a1 = cvt_pk_bf16(P[BASE + 2], P[BASE + 3]);   \
    unsigned b0 = cvt_pk_bf16(P[BASE + 4], P[BASE + 5]), b1 = cvt_pk_bf16(P[BASE + 6], P[BASE + 7]);                              \
    auto r0 = __builtin_amdgcn_permlane32_swap(a0, b0, false, false); auto r1 = __builtin_amdgcn_permlane32_swap(a1, b1, false, false); \
    u32x4 w = {r0[0], r1[0], r0[1], r1[1]}; OUT = __builtin_bit_cast(bf16x8, w); } while (0)
    PK4(p0, 0, pa0); PK4(p0, 8, pa1); PK4(p1, 0, pa2); PK4(p1, 8, pa3);
#undef PK4
}
template <int DQK> __device__ __forceinline__ void qkt(f32x16& p0, f32x16& p1, const char* Ks, const bf16x8* qr, int r32, int hi) {
    p0 = f32x16{}; p1 = f32x16{};
#pragma unroll
    for (int d0 = 0; d0 < DQK / 16; ++d0) { const int cb = (d0 * 16 + hi * 8) * 2, ci = 0;
        const bf16x8 b0 = *reinterpret_cast<const bf16x8*>(Ks + kswz<DQK>(r32, cb) + ci);
        const bf16x8 b1 = *reinterpret_cast<const bf16x8*>(Ks + kswz<DQK>(r32, cb) + ci + 32 * (DQK * 2));
        p0 = __builtin_amdgcn_mfma_f32_32x32x16_bf16(b0, qr[d0], p0, 0, 0, 0);
        p1 = __builtin_amdgcn_mfma_f32_32x32x16_bf16(b1, qr[d0], p1, 0, 0, 0); }
}
template <int DQK, int NREG> __device__ __forceinline__ void qkt_mix(f32x16& p0, f32x16& p1, const char* Ks, const bf16x8* qr, const char* qs, int r32, int hi) {
    p0 = f32x16{}; p1 = f32x16{};
#pragma unroll
    for (int d0 = 0; d0 < DQK / 16; ++d0) { const int cb = (d0 * 16 + hi * 8) * 2, ci = 0;
        const bf16x8 b0 = *reinterpret_cast<const bf16x8*>(Ks + kswz<DQK>(r32, cb) + ci);
        const bf16x8 b1 = *reinterpret_cast<const bf16x8*>(Ks + kswz<DQK>(r32, cb) + ci + 32 * (DQK * 2));
        bf16x8 q; if (d0 < NREG) q = qr[d0]; else q = *reinterpret_cast<const bf16x8*>(qs + (d0 - NREG) * 1024);
        p0 = __builtin_amdgcn_mfma_f32_32x32x16_bf16(b0, q, p0, 0, 0, 0);
        p1 = __builtin_amdgcn_mfma_f32_32x32x16_bf16(b1, q, p1, 0, 0, 0); }
}
template <int DQK> __device__ __forceinline__ void qkt_ld(f32x16& p0, f32x16& p1, const char* Ks, const bf16_t* qw, int r32, int hi) {
    p0 = f32x16{}; p1 = f32x16{};
#pragma unroll
    for (int d0 = 0; d0 < DQK / 16; ++d0) { const int cb = (d0 * 16 + hi * 8) * 2, ci = 0;
        const bf16x8 q = *(const bf16x8*)(qw + d0 * 16);
        const bf16x8 b0 = *reinterpret_cast<const bf16x8*>(Ks + kswz<DQK>(r32, cb) + ci);
        const bf16x8 b1 = *reinterpret_cast<const bf16x8*>(Ks + kswz<DQK>(r32, cb) + ci + 32 * (DQK * 2));
        p0 = __builtin_amdgcn_mfma_f32_32x32x16_bf16(b0, q, p0, 0, 0, 0);
        p1 = __builtin_amdgcn_mfma_f32_32x32x16_bf16(b1, q, p1, 0, 0, 0); SBAR(); }
}
__device__ __forceinline__ int v_st(int k, int c) { const int kk = (k & ~0xC) | ((k & 4) << 1) | ((k & 8) >> 1); return ((kk >> 3) * 4 + (c >> 5)) * 512 + ((kk & 7) * 32 + (c & 31)) * 2; }
__device__ __forceinline__ int v_rd_base(int lane) { return ((lane & 3) << 3) | (((lane >> 2) & 3) << 6) | (((lane >> 4) & 1) << 5) | (((lane >> 5) & 1) << 8); }
constexpr int v_rd_off(int d0, int ks, int half) { return d0 * 512 + ks * 4096 + half * 2048; }
template <int OFF> __device__ __forceinline__ s16x4 tr_read(int vb) {
    s16x4 r; asm volatile("ds_read_b64_tr_b16 %0, %1 offset:%2" : "=&v"(r) : "v"(vb), "i"(OFF) : "memory"); return r;
}
template <int D0> __device__ __forceinline__ void pv_one(f32x16& od, int vb, bf16x8 pa0, bf16x8 pa1, bf16x8 pa2, bf16x8 pa3) {
    const s16x4 l0 = tr_read<v_rd_off(D0, 0, 0)>(vb), h0 = tr_read<v_rd_off(D0, 0, 1)>(vb), l1 = tr_read<v_rd_off(D0, 1, 0)>(vb), h1 = tr_read<v_rd_off(D0, 1, 1)>(vb);
    const s16x4 l2 = tr_read<v_rd_off(D0, 2, 0)>(vb), h2 = tr_read<v_rd_off(D0, 2, 1)>(vb), l3 = tr_read<v_rd_off(D0, 3, 0)>(vb), h3 = tr_read<v_rd_off(D0, 3, 1)>(vb);
    asm volatile("s_waitcnt lgkmcnt(0)" ::: "memory"); SBAR();
#define PK(L, H) (bf16x8){L[0], L[1], L[2], L[3], H[0], H[1], H[2], H[3]}
    od = __builtin_amdgcn_mfma_f32_32x32x16_bf16(pa0, PK(l0, h0), od, 0, 0, 0);
    od = __builtin_amdgcn_mfma_f32_32x32x16_bf16(pa1, PK(l1, h1), od, 0, 0, 0);
    od = __builtin_amdgcn_mfma_f32_32x32x16_bf16(pa2, PK(l2, h2), od, 0, 0, 0);
    od = __builtin_amdgcn_mfma_f32_32x32x16_bf16(pa3, PK(l3, h3), od, 0, 0, 0);
#undef PK
}
__device__ __forceinline__ void pv_d0(f32x16* o, int vb, bf16x8 pa0, bf16x8 pa1, bf16x8 pa2, bf16x8 pa3) {
    pv_one<0>(o[0], vb, pa0, pa1, pa2, pa3); pv_one<1>(o[1], vb, pa0, pa1, pa2, pa3); pv_one<2>(o[2], vb, pa0, pa1, pa2, pa3); pv_one<3>(o[3], vb, pa0, pa1, pa2, pa3);
}

template <int DQK, int LDQ, int LDO, bool FAST, int SD>
__device__ __forceinline__ void attn_unit(const bf16_t* Qb, const bf16_t* __restrict__ Kh, const bf16_t* __restrict__ Vh, bf16_t* Ob,
                                          char* lds) {
    constexpr int SHM_K = KVBLK * DQK * 2, ND0 = DQK / 16;
    int tid_ = threadIdx.x; asm volatile("" : "+v"(tid_));
    const int tid = tid_, wid = tid >> 6, lane = tid & 63, r32 = lane & 31, hi = lane >> 5;
    char* V_lds = lds; char* K_lds = lds + OFF_K;
    float* ws = (float*)(lds + OFF_WS) + wid * 64; float* li_l = ws; float* al_l = ws + 32;
    float m_reg = -1e30f, l_reg = 0; f32x16 o[4] = {};
    const bf16_t* Qw0 = Qb + (size_t)(wid * QBLK + r32) * LDQ + hi * 8;
#define QLOAD() const bf16_t* qw_ = Qw0; asm volatile("" : "+v"(qw_))
    const int sr = tid >> 4, sc = (tid & 15) * 8, vst0 = v_st(sr, sc), vst1 = v_st(32 + sr, sc);
    const int krow = (DQK == 128) ? sr : (tid >> 3), kcol = (DQK == 128) ? sc : (tid & 7) * 8;
    const int kst0 = kswz<DQK>(krow, kcol * 2), kst1 = kswz<DQK>(32 + krow, kcol * 2);
    const int vb0 = (int)(uintptr_t)V_lds + v_rd_base(lane);
    struct { bf16x8 vs0, vs1, ks0, ks1; } sr_[SD];
#define SLOAD(i, k0) do { sr_[i].vs0 = *(const bf16x8*)(&Vh[(size_t)((k0) + sr) * LDK + sc]); sr_[i].vs1 = *(const bf16x8*)(&Vh[(size_t)((k0) + 32 + sr) * LDK + sc]); \
    sr_[i].ks0 = *(const bf16x8*)(&Kh[(size_t)((k0) + krow) * LDK + kcol]); if (DQK == 128) sr_[i].ks1 = *(const bf16x8*)(&Kh[(size_t)((k0) + 32 + krow) * LDK + kcol]); } while (0)
#define SWRITE(b, i) do { *(bf16x8*)(V_lds + (b) * SHM_V + vst0) = sr_[i].vs0; *(bf16x8*)(V_lds + (b) * SHM_V + vst1) = sr_[i].vs1; \
    *(bf16x8*)(K_lds + (b) * SHM_K + kst0) = sr_[i].ks0; if (DQK == 128) *(bf16x8*)(K_lds + (b) * SHM_K + kst1) = sr_[i].ks1; } while (0)
#define SWAIT() do { if (SD == 1) asm volatile("s_waitcnt vmcnt(0)" ::: "memory"); else if (DQK == 128) asm volatile("s_waitcnt vmcnt(4)" ::: "memory"); else asm volatile("s_waitcnt vmcnt(3)" ::: "memory"); } while (0)
#define RESC(a) do { if (!FAST && __any((a) < 1.f)) { if (hi == 0) al_l[r32] = (a); asm volatile("s_waitcnt lgkmcnt(0)" ::: "memory"); \
    _Pragma("unroll") for (int d = 0; d < 4; ++d) _Pragma("unroll") for (int r = 0; r < 16; ++r) o[d][r] *= al_l[crow(r, hi)]; } } while (0)
    f32x16 pA0, pA1, pB0, pB1; float mnA, mnB, alA, alB; bf16x8 pa0, pa1, pa2, pa3; constexpr int NT = SKV / KVBLK;
    constexpr int SE = 0, SO = SD - 1;
    SLOAD(SE, 0); asm volatile("s_waitcnt vmcnt(0)" ::: "memory"); SWRITE(0, SE); __syncthreads();
    { QLOAD(); qkt_ld<DQK>(pA0, pA1, K_lds, qw_, r32, hi); } partialSM<FAST>(pA0, pA1, m_reg, mnA, alA);
    SLOAD(SO, KVBLK); if (SD == 2) SLOAD(SE, 2 * KVBLK);
    SWAIT(); SWRITE(1, SO); __syncthreads();
    for (int j = 1; j + 1 < NT; j += 2) {
        SBAR(); { QLOAD(); qkt_ld<DQK>(pB0, pB1, K_lds + SHM_K, qw_, r32, hi); }
        finishSM<FAST>(pA0, pA1, alA, l_reg, pa0, pa1, pa2, pa3); SBAR();
        SLOAD(SO, (j + SD) * KVBLK); SBAR();
        pv_d0(o, vb0, pa0, pa1, pa2, pa3); partialSM<FAST>(pB0, pB1, m_reg, mnB, alB);
        __syncthreads(); SWAIT(); SWRITE(0, SE);
        RESC(alB); __syncthreads();
        SBAR(); { QLOAD(); qkt_ld<DQK>(pA0, pA1, K_lds, qw_, r32, hi); }
        finishSM<FAST>(pB0, pB1, alB, l_reg, pa0, pa1, pa2, pa3); SBAR();
        if (SD == 1 || j + 3 < NT) SLOAD(SE, (j + 1 + SD) * KVBLK); SBAR();
        pv_d0(o, vb0 + SHM_V, pa0, pa1, pa2, pa3); partialSM<FAST>(pA0, pA1, m_reg, mnA, alA);
        __syncthreads(); SWAIT(); SWRITE(1, SO);
        RESC(alA); __syncthreads();
    }
    SBAR(); { QLOAD(); qkt_ld<DQK>(pB0, pB1, K_lds + SHM_K, qw_, r32, hi); }
    finishSM<FAST>(pA0, pA1, alA, l_reg, pa0, pa1, pa2, pa3); SBAR();
    pv_d0(o, vb0, pa0, pa1, pa2, pa3); partialSM<FAST>(pB0, pB1, m_reg, mnB, alB);
    __syncthreads(); RESC(alB);
    finishSM<FAST>(pB0, pB1, alB, l_reg, pa0, pa1, pa2, pa3); SBAR();
    pv_d0(o, vb0 + SHM_V, pa0, pa1, pa2, pa3);
    if (FAST) { auto rr = __builtin_amdgcn_permlane32_swap(__float_as_uint(l_reg), __float_as_uint(l_reg), false, false); l_reg = __uint_as_float(rr[0]) + __uint_as_float(rr[1]); }
    if (hi == 0) li_l[r32] = l_reg; asm volatile("s_waitcnt lgkmcnt(0)" ::: "memory");
    float rli[16];
#pragma unroll
    for (int r = 0; r < 16; ++r) rli[r] = __builtin_amdgcn_rcpf(li_l[crow(r, hi)]);
    __syncthreads();
    {
        bf16_t* stg = (bf16_t*)lds + wid * 4096;
#pragma unroll
        for (int r = 0; r < 16; ++r) { const int orow = crow(r, hi);
#pragma unroll
            for (int d0 = 0; d0 < 4; ++d0) { const float v = o[d0][r] * rli[r]; stg[orow * 128 + d0 * 32 + r32] = (bf16_t)(cvt_pk_bf16(v, v) & 0xffffu); } }
        asm volatile("s_waitcnt lgkmcnt(0)" ::: "memory");
        bf16_t* Ow = Ob + (size_t)(wid * QBLK) * LDO;
#pragma unroll
        for (int i = 0; i < 8; ++i) { const int row = i * 4 + (lane >> 4), ch = lane & 15; const u32x4 v = *(const u32x4*)(stg + row * 128 + ch * 8);
            *(u32x4*)(Ow + (size_t)row * LDO + ch * 8) = v; }
    }
    __syncthreads();
#undef QLOAD
#undef SLOAD
#undef SWRITE
#undef SWAIT
#undef RESC
}

__device__ __forceinline__ void glds16(const void* gsrc, unsigned lds_dst) { unsigned keep;
    asm volatile("s_mov_b32 %0, m0\n\ts_mov_b32 m0, %2\n\ts_nop 0\n\tglobal_load_lds_dwordx4 %1, off\n\ts_mov_b32 m0, %0" : "=&s"(keep) : "v"(gsrc), "s"(lds_dst) : "memory"); }
template <int DQK, int LDQ, int LDO>
__device__ __forceinline__ void attn_unit_fast(const bf16_t* Qb, const bf16_t* __restrict__ Kh, const bf16_t* __restrict__ Vh, bf16_t* Ob, char* lds,
                                               int mode = 0, float lam = 0.f, const float* __restrict__ sg = nullptr) {
    constexpr int SHM_K = KVBLK * DQK * 2, ND0 = DQK / 16, NT = SKV / KVBLK;
    constexpr int NQL = (DQK == 128) ? 2 : 0, NREG = ND0 - NQL;
    constexpr bool EARLY = (DQK == 64);
    static_assert(NT % 2 == 0 && NT >= 4, "even tile count");
    int tid_ = threadIdx.x; if (DQK == 128) asm volatile("" : "+v"(tid_));
    const int tid = tid_, wid = tid >> 6, lane = tid & 63, r32 = lane & 31, hi = lane >> 5;
    const bool isY = false;
    char* V_lds = lds; char* K_lds = lds + OFF_K;
    float l_reg = 0, dummy_m = 0, dummy_a = 1.f; f32x16 o[4] = {}; bf16x8 qr[NREG];
    char* qs = lds + OFF_Q + wid * (2 * 1024) + lane * 16;
    {
        const bf16_t* Qw = Qb + (size_t)(wid * QBLK + r32) * LDQ + hi * 8;
#pragma unroll
        for (int d0 = 0; d0 < NREG; ++d0) qr[d0] = *(const bf16x8*)(Qw + d0 * 16);
#pragma unroll
        for (int d0 = NREG; d0 < ND0; ++d0) *(bf16x8*)(qs + (d0 - NREG) * 1024) = *(const bf16x8*)(Qw + d0 * 16);
    }
    const int widu = __builtin_amdgcn_readfirstlane(wid);
    const int vb0 = (int)(uintptr_t)V_lds + v_rd_base(lane);
    unsigned ksrc[2], vsrc[2];
#pragma unroll
    for (int i = 0; i < 2; ++i) {
        if (DQK == 128) { const int j = wid * 2 + i, row = 4 * j + (lane >> 4), c = (lane & 15) ^ (row & 15); ksrc[i] = (unsigned)(row * LDK + c * 8) * 2u; }
        else { const int row = 8 * wid + (lane >> 3), c = (lane & 7) ^ ((row >> 1) & 7); ksrc[i] = (unsigned)(row * LDK + c * 8) * 2u; }
        const int j = wid * 2 + i, st = 2 * j + (lane >> 5), kk = (st >> 2) * 8 + ((lane & 31) >> 2), c = (st & 3) * 32 + (lane & 3) * 8;
        const int k = (kk & ~0xC) | ((kk & 4) << 1) | ((kk & 8) >> 1);
        vsrc[i] = (unsigned)(k * LDK + c) * 2u;
    }
    constexpr size_t TILEB = (size_t)KVBLK * LDK * 2;
    const unsigned lds0 = (unsigned)(uintptr_t)lds;
#define DMA_K(t, buf) do { const char* kb_ = (const char*)Kh + (size_t)(t) * TILEB; \
        glds16(kb_ + ksrc[0], (unsigned)__builtin_amdgcn_readfirstlane(lds0 + OFF_K + (buf) * SHM_K + (DQK == 128 ? widu * 2048 : widu * 1024))); \
        if (DQK == 128) glds16(kb_ + ksrc[1], (unsigned)__builtin_amdgcn_readfirstlane(lds0 + OFF_K + (buf) * SHM_K + widu * 2048 + 1024)); } while (0)
#define DMA_V(t, buf) do { const char* vb_ = (const char*)Vh + (size_t)(t) * TILEB; \
        glds16(vb_ + vsrc[0], (unsigned)__builtin_amdgcn_readfirstlane(lds0 + (buf) * SHM_V + widu * 2048)); \
        glds16(vb_ + vsrc[1], (unsigned)__builtin_amdgcn_readfirstlane(lds0 + (buf) * SHM_V + widu * 2048 + 1024)); } while (0)
#define WBAR0() do { asm volatile("s_waitcnt vmcnt(0)" ::: "memory"); __syncthreads(); } while (0)
#define EXPH(P) do { _Pragma("unroll") for (int r = 0; r < 16; ++r) P[r] = __builtin_amdgcn_exp2f(P[r]); } while (0)
    f32x16 pA0, pA1, pB0, pB1; bf16x8 pa0, pa1, pa2, pa3;
    DMA_K(0, 0); WBAR0();
    if (__builtin_amdgcn_readfirstlane(tid_) >= 256) __builtin_amdgcn_s_setprio(1);
    DMA_K(1, 1); DMA_V(0, 0); SBAR();
    qkt_mix<DQK, NREG>(pA0, pA1, K_lds, qr, qs, r32, hi); if (!isY) { EXPH(pA0); }
    WBAR0();
    for (int k = 1; k + 1 < NT; k += 2) {
        DMA_K(k + 1, 0); DMA_V(k, 1); SBAR();
        if (isY) { EXPH(pA0); }
        SBAR(); qkt_mix<DQK, NREG>(pB0, pB1, K_lds + SHM_K, qr, qs, r32, hi);
        finishSM<true>(pA0, pA1, dummy_a, l_reg, pa0, pa1, pa2, pa3); SBAR();
        pv_d0(o, vb0, pa0, pa1, pa2, pa3);
        if (!isY) { EXPH(pB0); }
        WBAR0();
        DMA_K(k + 2, 1); DMA_V(k + 1, 0); SBAR();
        if (isY) { EXPH(pB0); }
        SBAR(); qkt_mix<DQK, NREG>(pA0, pA1, K_lds, qr, qs, r32, hi);
        finishSM<true>(pB0, pB1, dummy_a, l_reg, pa0, pa1, pa2, pa3); SBAR();
        pv_d0(o, vb0 + SHM_V, pa0, pa1, pa2, pa3);
        if (!isY) { EXPH(pA0); }
        WBAR0();
    }
    DMA_V(NT - 1, 1); SBAR();
    if (isY) { EXPH(pA0); }
    SBAR(); qkt_mix<DQK, NREG>(pB0, pB1, K_lds + SHM_K, qr, qs, r32, hi);
    finishSM<true>(pA0, pA1, dummy_a, l_reg, pa0, pa1, pa2, pa3); SBAR();
    pv_d0(o, vb0, pa0, pa1, pa2, pa3);
    if (!isY) { EXPH(pB0); }
    WBAR0();
    if (isY) { EXPH(pB0); }
    SBAR(); finishSM<true>(pB0, pB1, dummy_a, l_reg, pa0, pa1, pa2, pa3); SBAR();
    pv_d0(o, vb0 + SHM_V, pa0, pa1, pa2, pa3);
    __builtin_amdgcn_s_setprio(0);
    (void)dummy_m;
    { auto rr = __builtin_amdgcn_permlane32_swap(__float_as_uint(l_reg), __float_as_uint(l_reg), false, false); l_reg = __uint_as_float(rr[0]) + __uint_as_float(rr[1]); }
    {
        int t2 = threadIdx.x; asm volatile("" : "+v"(t2));
        const int wid2 = t2 >> 6, lane2 = t2 & 63, r32b = lane2 & 31, hib = lane2 >> 5;
        float* li2 = (float*)(lds + OFF_WS) + wid2 * 64;
        if (hib == 0) li2[r32b] = l_reg; asm volatile("s_waitcnt lgkmcnt(0)" ::: "memory");
        __syncthreads();
        bf16_t* stash = (bf16_t*)(lds + OFF_Q) + wid2 * 4096;
        bf16_t* stg = (mode == 1) ? stash : ((bf16_t*)lds + wid2 * 4096);
#pragma unroll
        for (int r = 0; r < 16; ++r) { const int orow = crow(r, hib); const float rl = __builtin_amdgcn_rcpf(li2[orow]);
#pragma unroll
            for (int d0 = 0; d0 < 4; ++d0) { const float v = o[d0][r] * rl; stg[orow * 128 + d0 * 32 + r32b] = (bf16_t)(cvt_pk_bf16(v, v) & 0xffffu); } }
        asm volatile("s_waitcnt lgkmcnt(0)" ::: "memory");
        if (mode != 1) {
            bf16_t* Ow = Ob + (size_t)(wid2 * QBLK) * LDO;
            const int ch = lane2 & 15;
            float gg[8];
            if (mode == 2) {
#pragma unroll
                for (int e = 0; e < 8; ++e) gg[e] = sg[ch * 8 + e] * 0.8f; }
#pragma unroll
            for (int i = 0; i < 8; ++i) { const int row = i * 4 + (lane2 >> 4); u32x4 v = *(const u32x4*)(stg + row * 128 + ch * 8);
                if (mode == 2) { const u32x4 v0 = *(const u32x4*)(stash + row * 128 + ch * 8); float x0[8], x1[8]; unpack8(v0, x0); unpack8(v, x1); float ss = 0.f;
#pragma unroll
                    for (int e = 0; e < 8; ++e) { x0[e] = x0[e] - lam * x1[e]; ss += x0[e] * x0[e]; }
                    ss += __shfl_xor(ss, 1); ss += __shfl_xor(ss, 2); ss += __shfl_xor(ss, 4); ss += __shfl_xor(ss, 8);
                    const float rstd = rsqrtf(ss * (1.0f / 128) + EPS);
#pragma unroll
                    for (int e = 0; e < 8; ++e) x0[e] = x0[e] * rstd * gg[e];
                    v = pack8(x0); }
                *(u32x4*)(Ow + (size_t)row * LDO + ch * 8) = v; }
        }
    }
    asm volatile("s_waitcnt vmcnt(0)" ::: "memory");
    __syncthreads();
#undef DMA_K
#undef DMA_V
#undef WBAR0
#undef EXPH
}
#undef SBAR
}

struct Args { const float* in[24]; float* out; unsigned char* ws; int ph_lo, ph_hi; };
enum { I_X = 0, I_C, I_CTX, I_CCTX, I_WADA, I_BADA, I_N1G, I_WIN, I_QNA, I_KNA, I_QNB, I_KNB, I_LQ1, I_LK1, I_LQ2, I_LK2, I_SUBLN, I_WBRA, I_WBRB, I_WOUT, I_N2G, I_WFG, I_WFU, I_WFD };
constexpr int NPHASES = 11;

__device__ __forceinline__ void transpose_item(const float* W, int K, int N, bf16_t* WT, int gu, LAS float* scr, int item, int lane) {
    const int nblk = N / 32, kb = item / nblk, nb = item % nblk, k0 = 64 * kb, n0 = 32 * nb;
#pragma unroll 8
    for (int i = 0; i < 32; ++i) { const int kk = 2 * i + (lane >> 5); scr[kk * 33 + (lane & 31)] = __builtin_nontemporal_load(&W[(size_t)(k0 + kk) * N + n0 + (lane & 31)]); }
    asm volatile("s_waitcnt lgkmcnt(0)" ::: "memory");
    const int c = lane & 7;
    const int rbase = (gu == 0 || gu == 3) ? n0 : (((n0 >> 7) << 8) + (n0 & 127) + (gu == 2 ? 128 : 0));
    const int hk = (gu != 3) ? 0 : ((n0 < 512 || (n0 >= 3072 && n0 < 5120)) ? 1 : (((n0 >= 1024 && n0 < 2048) || (n0 >= 5120 && n0 < 6144)) ? 2 : 0));
#pragma unroll
    for (int j = 0; j < 4; ++j) { const int n = (lane >> 3) + 8 * j; const LAS float* s = scr + (8 * c) * 33 + n;
        int rown = rbase + n;
        if (hk == 1) { const int i = (n0 & 127) + n; rown = (n0 & ~127) + ((i < 64) ? 2 * i : 2 * (i - 64) + 1); }
        else if (hk == 2) { const int i = (n0 & 63) + n; rown = (n0 & ~63) + ((i < 32) ? 2 * i : 2 * (i - 32) + 1); }
        u32x4 o; o.x = cvt_pk_bf16(s[0 * 33], s[1 * 33]); o.y = cvt_pk_bf16(s[2 * 33], s[3 * 33]); o.z = cvt_pk_bf16(s[4 * 33], s[5 * 33]); o.w = cvt_pk_bf16(s[6 * 33], s[7 * 33]);
        *(u32x4*)(WT + (size_t)rown * K + k0 + 8 * c) = o; }
    asm volatile("s_waitcnt lgkmcnt(0)" ::: "memory");
}

__device__ __forceinline__ void norm_chunk(const float* X, bf16_t* OUT, int row0, const LAS float* mA, const LAS float* mS, int wave, int lane, int rpw = 8) {
    for (int r = 0; r < rpw; ++r) {
        const int row = row0 + wave * rpw + r;
        const f32x4* xr = (const f32x4*)(X + (size_t)row * DM) + lane;
        f32x4 v[8]; float ss = 0.f;
#pragma unroll
        for (int j = 0; j < 8; ++j) { v[j] = __builtin_nontemporal_load(&xr[64 * j]); ss += (v[j].x * v[j].x + v[j].y * v[j].y) + (v[j].z * v[j].z + v[j].w * v[j].w); }
        ss = wave_sum(ss);
        const float rstd = rsqrtf(ss * (1.0f / DM) + EPS);
        u32x2* op = (u32x2*)(OUT + (size_t)row * DM) + lane;
#pragma unroll
        for (int j = 0; j < 8; ++j) { const int col = 4 * lane + 256 * j; const f32x4 a = *(const LAS f32x4*)(mA + col), s = *(const LAS f32x4*)(mS + col);
            const f32x4 ov = v[j] * rstd * a + s; u32x2 w; w.x = cvt_pk_bf16(ov.x, ov.y); w.y = cvt_pk_bf16(ov.z, ov.w); op[64 * j] = w; }
    }
}

__device__ __forceinline__ void nr128(bf16_t* p, const float* g, bool rope, float prow, float pcol, int lane, float osc) {
    const u32x4 raw = *(const u32x4*)p; float x[8]; unpack8(raw, x); float ss = 0.f;
#pragma unroll
    for (int e = 0; e < 8; ++e) ss += x[e] * x[e];
    ss += __shfl_xor(ss, 1); ss += __shfl_xor(ss, 2); ss += __shfl_xor(ss, 4); ss += __shfl_xor(ss, 8);
    const float rstd = rsqrtf(ss * (1.0f / 128) + EPS); const int idx0 = (lane & 15) * 8;
#pragma unroll
    for (int e = 0; e < 8; ++e) x[e] = x[e] * rstd * g[idx0 + e];
    if (rope) { const bool lo_half = (lane & 8) == 0; const int i0 = idx0 & 63;
#pragma unroll
        for (int e = 0; e < 8; ++e) { const float pp = __shfl_xor(x[e], 8); const int i = i0 + e, f = i & 31;
            const float ang = ((i < 32) ? prow : pcol) * __builtin_amdgcn_exp2f(-(float)f * (13.287712379549449f / 32));
            const float c = __cosf(ang), sn = __sinf(ang);
            x[e] = lo_half ? (x[e] * c - pp * sn) : (x[e] * c + pp * sn); } }
#pragma unroll
    for (int e = 0; e < 8; ++e) x[e] *= osc;
    *(u32x4*)p = pack8(x);
}
__device__ __forceinline__ void nr64(bf16_t* p, const float* g, bool rope, float prow, float pcol, int lane, float osc) {
    const u32x4 raw = *(const u32x4*)p; float x[8]; unpack8(raw, x); float ss = 0.f;
#pragma unroll
    for (int e = 0; e < 8; ++e) ss += x[e] * x[e];
    ss += __shfl_xor(ss, 1); ss += __shfl_xor(ss, 2); ss += __shfl_xor(ss, 4);
    const float rstd = rsqrtf(ss * (1.0f / 64) + EPS); const int idx0 = (lane & 7) * 8;
#pragma unroll
    for (int e = 0; e < 8; ++e) x[e] = x[e] * rstd * g[idx0 + e];
    if (rope) { const bool lo_half = (lane & 4) == 0; const int i0 = idx0 & 31;
#pragma unroll
        for (int e = 0; e < 8; ++e) { const float pp = __shfl_xor(x[e], 4); const int i = i0 + e, f = i & 15;
            const float ang = ((i < 16) ? prow : pcol) * __builtin_amdgcn_exp2f(-(float)f * (13.287712379549449f / 16));
            const float c = __cosf(ang), sn = __sinf(ang);
            x[e] = lo_half ? (x[e] * c - pp * sn) : (x[e] * c + pp * sn); } }
#pragma unroll
    for (int e = 0; e < 8; ++e) x[e] *= osc;
    *(u32x4*)p = pack8(x);
}

__device__ __forceinline__ void light_grid_barrier(unsigned* ctr, unsigned target) {
    asm volatile("s_waitcnt vmcnt(0)" ::: "memory");
    __syncthreads();
    if (threadIdx.x == 0) {
        __builtin_amdgcn_fence(__ATOMIC_RELEASE, "agent");
        asm volatile("s_waitcnt vmcnt(0)" ::: "memory");
        (void)__hip_atomic_fetch_add(ctr, 1u, __ATOMIC_RELAXED, __HIP_MEMORY_SCOPE_AGENT);
        unsigned spins = 0;
        while (__hip_atomic_load(ctr, __ATOMIC_RELAXED, __HIP_MEMORY_SCOPE_AGENT) < target) { __builtin_amdgcn_s_sleep(2); if (++spins > (1u << 23)) break; }
        __builtin_amdgcn_fence(__ATOMIC_ACQUIRE, "agent");
        asm volatile("s_waitcnt vmcnt(0)" ::: "memory");
    }
    __syncthreads();
}

#define XB_TMO      128
#define XB_XCNT(j)  (256  + 64 * (j))
#define XB_XSUB(j)  (1280 + 64 * (j))
#define XB_XGEN(j)  (2304 + 64 * (j))
#define XB_TOP      3328
#define XB_TOPGEN   3392
#define XCD_BAR_WORDS 3456
#define XB_SPIN_CAP (1u << 18)
__device__ __forceinline__ unsigned xb_ld(unsigned* p)              { return __hip_atomic_load(p, __ATOMIC_RELAXED, __HIP_MEMORY_SCOPE_AGENT); }
__device__ __forceinline__ unsigned xb_add(unsigned* p, unsigned v) { return __hip_atomic_fetch_add(p, v, __ATOMIC_RELAXED, __HIP_MEMORY_SCOPE_AGENT); }
__device__ __forceinline__ unsigned xb_xcc_id() { return (unsigned)__builtin_amdgcn_s_getreg((3 << 11) | 20) & 0xFu; }
#define XB_SPIN(cond, bar) do { unsigned _sp = 0; while (cond) { __builtin_amdgcn_s_sleep(1); \
    if ((++_sp & 255u) == 0u) { if (xb_ld(&(bar)[XB_TMO])) break; if (_sp > XB_SPIN_CAP) { atomicAdd(&(bar)[XB_TMO], 1u); break; } } } } while (0)
struct XcdBarrier { unsigned* bar; unsigned x; volatile LAS unsigned* st; };
__device__ __forceinline__ XcdBarrier xcd_barrier_post(unsigned* bar, volatile LAS unsigned* st) {
    XcdBarrier b; b.bar = bar; b.x = xb_xcc_id(); b.st = st;
    if (threadIdx.x == 0) (void)xb_add(&bar[XB_XCNT(b.x)], 1u);
    return b;
}
__device__ __forceinline__ void xcd_barrier_complete(unsigned* bar, unsigned x, unsigned& nloc, unsigned& nx) {
    const unsigned G = gridDim.x * gridDim.y * gridDim.z;
    unsigned sum, cnt, mine, sp = 0u;
    for (;;) {
        sum = 0u; cnt = 0u; mine = 0u;
#pragma unroll
        for (unsigned j = 0; j < 16; ++j) { const unsigned c = xb_ld(&bar[XB_XCNT(j)]); sum += c; cnt += (c > 0u) ? 1u : 0u; mine = (j == x) ? c : mine; }
        if (sum == G) break;
        __builtin_amdgcn_s_sleep(1);
        if ((++sp & 255u) == 0u) { if (xb_ld(&bar[XB_TMO])) break; if (sp > XB_SPIN_CAP) { atomicAdd(&bar[XB_TMO], 1u); break; } }
    }
    nloc = mine > 0u ? mine : 1u; nx = cnt > 0u ? cnt : 1u;
}
__device__ __forceinline__ void xcd_barrier(const XcdBarrier& b) {
    asm volatile("s_waitcnt vmcnt(0)" ::: "memory");
    __syncthreads();
    if (threadIdx.x == 0) {
        unsigned* bar = b.bar;
        __builtin_amdgcn_s_waitcnt(0);
        unsigned nloc = b.st[0], nx = b.st[1];
        if (nloc == 0u) { xcd_barrier_complete(bar, b.x, nloc, nx); b.st[0] = nloc; b.st[1] = nx; }
        const unsigned old = xb_add(&bar[XB_XSUB(b.x)], 1u);
        const unsigned gen = old / nloc;
        if (old + 1u == (gen + 1u) * nloc) {
            __builtin_amdgcn_fence(__ATOMIC_RELEASE, "agent");
            asm volatile("s_waitcnt vmcnt(0)" ::: "memory");
            const unsigned og = xb_add(&bar[XB_TOP], 1u);
            const unsigned tg = og / nx;
            if (og + 1u == (tg + 1u) * nx) xb_add(&bar[XB_TOPGEN], 1u);
            else XB_SPIN(xb_ld(&bar[XB_TOPGEN]) == tg, bar);
            __builtin_amdgcn_fence(__ATOMIC_ACQUIRE, "agent");
            xb_add(&bar[XB_XGEN(b.x)], 1u);
            asm volatile("s_waitcnt vmcnt(0)" ::: "memory");
        } else {
            XB_SPIN(xb_ld(&bar[XB_XGEN(b.x)]) == gen, bar);
            __builtin_amdgcn_fence(__ATOMIC_ACQUIRE, "agent");
            asm volatile("s_waitcnt vmcnt(0)" ::: "memory");
        }
    }
    __syncthreads();
}

__global__ void __launch_bounds__(NTHREADS, 2) fwd_kernel(Args a) {
    extern __shared__ __attribute__((aligned(16))) unsigned char lds[];
    LAS unsigned char* ldsl = (LAS unsigned char*)lds;
    const int G = gridDim.x, bx = blockIdx.x;
#define PHASE_IDS() int tid = threadIdx.x; asm volatile("" : "+v"(tid)); const int lane = tid & 63, wave = __builtin_amdgcn_readfirstlane(tid >> 6); (void)lane; (void)wave
    const int vcu = (G % 8 == 0) ? (bx % 8) * (G / 8) + bx / 8 : bx;
    unsigned char* ws = a.ws;
    float* MODP = (float*)(ws + WS_MODP); float* MOD = (float*)(ws + WS_MOD);
    bf16_t* WinT = (bf16_t*)(ws + WS_WIN); bf16_t* WdT = (bf16_t*)(ws + WS_WD); bf16_t* WbrAT = (bf16_t*)(ws + WS_WBRA); bf16_t* WbrBT = (bf16_t*)(ws + WS_WBRB);
    bf16_t* WoutT = (bf16_t*)(ws + WS_WOUT); bf16_t* WguT = (bf16_t*)(ws + WS_WGU);
    bf16_t* Hb = (bf16_t*)(ws + WS_H); bf16_t* KV = (bf16_t*)(ws + WS_KV); bf16_t* QG = (bf16_t*)(ws + WS_QG);
    bf16_t* OBraw = Hb; bf16_t* Tm = KV; bf16_t* HM = QG; bf16_t* H2 = Hb;
    const int lo = a.ph_lo, hi = a.ph_hi;
#ifndef PHMASK
#define PHMASK 0xFFFF
#endif
#define IN(k) (((PHMASK >> (k)) & 1) && lo <= (k) && (k) < hi)
    if (a.ph_hi > 4096) cg::this_grid().sync();
    volatile LAS unsigned* xb_st = (volatile LAS unsigned*)(ldsl + 139264);
    if (threadIdx.x < 4) xb_st[threadIdx.x] = 0u;
    __syncthreads();
    const XcdBarrier xbar = xcd_barrier_post((unsigned*)(ws + WS_BAR), xb_st);
#define SEAM(k) do { if (IN(k) && IN((k) + 1)) { xcd_barrier(xbar); } } while (0)

    if (IN(0)) for (int rep = 0; rep < NREP(0); ++rep) { if (rep) cg::this_grid().sync(); PHASE_IDS();
        LAS float* sc = (LAS float*)ldsl;
        LAS float* red = (LAS float*)(ldsl + 8192);
        const float* wada = a.in[I_WADA];
        typedef float f32x2_ __attribute__((ext_vector_type(2)));
        for (int it = bx; it < 96 * 8; it += G) {
            const int cc = it % 96, kc = it / 96;
            for (int idx = tid; idx < 1280; idx += NTHREADS) { const int cond = idx >> 8, kk = idx & 255;
                const float v = (cond < 4) ? a.in[I_C][cond * DM + kc * 256 + kk] : a.in[I_CCTX][kc * 256 + kk];
                sc[idx] = v / (1.0f + __expf(-v)); }
            __syncthreads();
            f32x2_ acc[5];
#pragma unroll
            for (int c5 = 0; c5 < 5; ++c5) acc[c5] = (f32x2_){0.f, 0.f};
            const float* wp = wada + (size_t)(kc * 256 + wave * 32) * ADAW + cc * 128 + lane * 2;
#pragma unroll 16
            for (int r = 0; r < 32; ++r) { const f32x2_ w2 = *(const f32x2_*)(wp + (size_t)r * ADAW);
#pragma unroll
                for (int c5 = 0; c5 < 5; ++c5) acc[c5] += sc[c5 * 256 + wave * 32 + r] * w2; }
#pragma unroll
            for (int c5 = 0; c5 < 5; ++c5) *(LAS f32x2_*)(red + (wave * 5 + c5) * 128 + lane * 2) = acc[c5];
            __syncthreads();
            for (int idx = tid; idx < 640; idx += NTHREADS) { const int cond = idx >> 7, col = idx & 127; float s = 0.f;
#pragma unroll
                for (int w = 0; w < 8; ++w) s += red[(w * 5 + cond) * 128 + col];
                MODP[(size_t)(kc * 5 + cond) * ADAW + cc * 128 + col] = s; }
            __syncthreads();
        }
        LAS float* scr = (LAS float*)(ldsl + wave * 16384);
        const int gw = vcu * NWAVES + wave, NGW = G * NWAVES;
        constexpr int I_1 = 32 * 320, I_2 = 32 * 64, I_3 = 16 * 64, I_4 = 32 * 64, I_5 = 32 * 176, I_6 = 32 * 176;
        constexpr int NITEMS = I_1 + I_2 + I_3 + I_4 + I_5 + I_6;
        for (int it = gw; it < NITEMS; it += NGW) {
            int r = it;
            if (r < I_1) { transpose_item(a.in[I_WIN], DM, INW, WinT, 3, scr, r, lane); continue; } r -= I_1;
            if (r < I_2) { transpose_item(a.in[I_WBRA], 2048, DM, WbrAT, 0, scr, r, lane); continue; } r -= I_2;
            if (r < I_3) { transpose_item(a.in[I_WBRB], 1024, DM, WbrBT, 0, scr, r, lane); continue; } r -= I_3;
            if (r < I_4) { transpose_item(a.in[I_WOUT], DM, DM, WoutT, 0, scr, r, lane); continue; } r -= I_4;
            if (r < I_5) { transpose_item(a.in[I_WFG], DM, DFF, WguT, 1, scr, r, lane); continue; } r -= I_5;
            transpose_item(a.in[I_WFU], DM, DFF, WguT, 2, scr, r, lane);
        }
        __syncthreads();
    }
    SEAM(0);

    if (IN(1)) for (int rep = 0; rep < NREP(1); ++rep) { if (rep) cg::this_grid().sync(); PHASE_IDS();
        LAS float* mA = (LAS float*)ldsl; LAS float* mS = mA + DM;
        const float* bada = a.in[I_BADA]; const float* g1 = a.in[I_N1G];
        for (int q = bx; q < 512; q += G) {
            const int cond = q < 256 ? (q >> 6) : 4;
            __syncthreads();
            for (int col = tid; col < DM; col += NTHREADS) { float sh = bada[col], scl = bada[DM + col];
#pragma unroll
                for (int kc = 0; kc < 8; ++kc) { sh += MODP[(size_t)(kc * 5 + cond) * ADAW + col]; scl += MODP[(size_t)(kc * 5 + cond) * ADAW + DM + col]; }
                mA[col] = g1[col] * (1.0f + scl); mS[col] = sh; }
            __syncthreads();
            if (q < 256) norm_chunk(a.in[I_X], Hb, q * 64, mA, mS, wave, lane);
            else if (wave < 4) norm_chunk(a.in[I_CTX], Hb + (size_t)MLAT * DM, (q - 256) * 4, mA, mS, wave, lane, 1);
        }
        for (int idx = bx * NTHREADS + tid; idx < 5 * ADAW; idx += G * NTHREADS) { const int cond = idx / ADAW, j = idx % ADAW; float v = bada[j];
#pragma unroll
            for (int kc = 0; kc < 8; ++kc) v += MODP[(size_t)(kc * 5 + cond) * ADAW + j];
            MOD[idx] = v; }
        __syncthreads();
    }
    SEAM(1);

    if (IN(2)) for (int rep = 0; rep < NREP(2); ++rep) { if (rep) cg::this_grid().sync(); PHASE_IDS();
        pg8::Gemm g{Hb, WinT, DM, DM, DM}; pg8::InprojOrder S; S.init(G, bx);
        pg8::EpiInproj E{KV, QG, a.in[I_KNA], a.in[I_KNB], a.in[I_QNA], a.in[I_QNB], (LAS float*)(ldsl + pg8::STAGE_BYTES)};
        pg8::gemm_phase<pg8::EpiInproj, pg8::InprojOrder>(ldsl, g, S, E);
    }
    SEAM(2);


    if (IN(4)) for (int rep = 0; rep < NREP(4); ++rep) { if (rep) cg::this_grid().sync(); PHASE_IDS();
        bool fastA;
        { float gmq = fmaxf(fabsf(a.in[I_QNA][lane]), fabsf(a.in[I_QNA][lane + 64])), gmk = fmaxf(fabsf(a.in[I_KNA][lane]), fabsf(a.in[I_KNA][lane + 64]));
#pragma unroll
          for (int o = 1; o < 64; o <<= 1) { gmq = fmaxf(gmq, __shfl_xor(gmq, o)); gmk = fmaxf(gmk, __shfl_xor(gmk, o)); }
          fastA = __uint_as_float(__builtin_amdgcn_readfirstlane(__float_as_uint((11.313708499f * 1.4426950408889634f * 1.02f) * gmq * gmk))) <= 60.f; }
#define ATT_A_LOOP(FASTV) for (int L = vcu; L < 1024; L += G) { \
            const int grp = L >> 6, rem = L & 63, b = grp >> 2, kvh = grp & 3, h = kvh * 4 + (rem >> 4), qb = rem & 15; \
            bf16_t* Qb = QG + (size_t)(b * SEQ + qb * 256) * QGW + h * 128; \
            const bf16_t* Kh = KV + (size_t)b * SKV * KVW + kvh * 128; const bf16_t* Vh = Kh + 512; \
            bf16_t* Ob = (NREP(4) == 2 && rep == 0) ? (bf16_t*)(ws + WS_WIN + 24 * MiB) : Qb; \
            if (FASTV) att::attn_unit_fast<128, QGW, QGW>(Qb, Kh, Vh, Ob, (char*)lds); else att::attn_unit<128, QGW, QGW, false, 1>(Qb, Kh, Vh, Ob, (char*)lds); }
#define ATT_B_FALLBACK() for (int L2 = vcu; L2 < 1024; L2 += G) { \
            const int grp = L2 >> 5, rem = L2 & 31, b = grp >> 3, h = grp & 7, sub = rem >> 4, qb = rem & 15; \
            const bf16_t* Qb = QG + (size_t)(b * SEQ + qb * 256) * QGW + 2048 + (h * 2 + sub) * 64; \
            const bf16_t* Kh = KV + (size_t)b * SKV * KVW + 1024 + (h * 2 + sub) * 64; const bf16_t* Vh = KV + (size_t)b * SKV * KVW + 2048 + h * 128; \
            bf16_t* Ob = OBraw + (size_t)(b * SEQ + qb * 256) * DM + (h * 2 + sub) * 128; \
            att::attn_unit<64, QGW, DM, false, 1>(Qb, Kh, Vh, Ob, (char*)lds); }
#define ATT_B_PAIRS() for (int L2 = vcu; L2 < 512; L2 += G) { \
            const int grp = L2 >> 4, b = grp >> 3, h = grp & 7, qb = L2 & 15; \
            const bf16_t* Qb = QG + (size_t)(b * SEQ + qb * 256) * QGW + 2048 + h * 128; \
            const bf16_t* Kh = KV + (size_t)b * SKV * KVW + 1024 + h * 128; const bf16_t* Vh = KV + (size_t)b * SKV * KVW + 2048 + h * 128; \
            att::attn_unit_fast<64, QGW, QGW>(Qb, Kh, Vh, nullptr, (char*)lds, 1); \
            att::attn_unit_fast<64, QGW, QGW>(Qb + 64, Kh + 64, Vh, QG + (size_t)(b * SEQ + qb * 256) * QGW + 2048 + h * 128, (char*)lds, 2, lam, a.in[I_SUBLN]); }
#define ATT_FENCE() do { asm volatile("" ::: "memory"); __builtin_amdgcn_sched_barrier(0); } while (0)
#ifndef ATT_X
#define ATT_X 15
#endif
        if (fastA) { if (ATT_X & 1) ATT_A_LOOP(true) } else { if (ATT_X & 2) ATT_A_LOOP(false) }
        ATT_FENCE();
        float lam; bool fastB;
        { int ln = threadIdx.x & 63; asm volatile("" : "+v"(ln));
          float g1_ = fabsf(a.in[I_QNB][ln]), g2_ = fabsf(a.in[I_KNB][ln]);
          float s1_ = a.in[I_LQ1][ln] * a.in[I_LK1][ln], s2_ = a.in[I_LQ2][ln] * a.in[I_LK2][ln];
#pragma unroll
          for (int o = 1; o < 64; o <<= 1) { g1_ = fmaxf(g1_, __shfl_xor(g1_, o)); g2_ = fmaxf(g2_, __shfl_xor(g2_, o)); s1_ += __shfl_xor(s1_, o); s2_ += __shfl_xor(s2_, o); }
          fastB = __uint_as_float(__builtin_amdgcn_readfirstlane(__float_as_uint((8.0f * 1.4426950408889634f * 1.02f) * g1_ * g2_))) <= 60.f;
          lam = __uint_as_float(__builtin_amdgcn_readfirstlane(__float_as_uint(expf(s1_) - expf(s2_) + 0.2f))); }
        if (fastB) { if (ATT_X & 4) ATT_B_PAIRS() } else { if (ATT_X & 8) ATT_B_FALLBACK() }
    }
    SEAM(4);
    bool p5_needed;
    { const int ln = threadIdx.x & 63; float g1_ = fabsf(a.in[I_QNB][ln]), g2_ = fabsf(a.in[I_KNB][ln]);
#pragma unroll
      for (int o = 1; o < 64; o <<= 1) { g1_ = fmaxf(g1_, __shfl_xor(g1_, o)); g2_ = fmaxf(g2_, __shfl_xor(g2_, o)); }
      p5_needed = !(__uint_as_float(__builtin_amdgcn_readfirstlane(__float_as_uint((8.0f * 1.4426950408889634f * 1.02f) * g1_ * g2_))) <= 60.f); }

    if (IN(5) && p5_needed) for (int rep = 0; rep < NREP(5); ++rep) { if (rep) cg::this_grid().sync(); PHASE_IDS();
        const int gw = vcu * NWAVES + wave, NGW = G * NWAVES;
        const float s1 = wave_sum(a.in[I_LQ1][lane] * a.in[I_LK1][lane]), s2 = wave_sum(a.in[I_LQ2][lane] * a.in[I_LK2][lane]);
        const float lam_init = 0.2f, lam = expf(s1) - expf(s2) + lam_init;
        const int h = lane >> 3, e0 = (lane & 7) * 16; const float* sg = a.in[I_SUBLN];
        float gg[16];
#pragma unroll
        for (int e = 0; e < 16; ++e) gg[e] = sg[e0 + e] * (1.0f - lam_init);
        for (int t = gw; t < MLAT; t += NGW) {
            const bf16_t* src = OBraw + (size_t)t * DM + (h * 2) * 128 + e0;
            const u32x4 a0 = *(const u32x4*)src, a1 = *(const u32x4*)(src + 8), b0 = *(const u32x4*)(src + 128), b1 = *(const u32x4*)(src + 136);
            float x0[16], x1[16]; unpack8(a0, x0); unpack8(a1, x0 + 8); unpack8(b0, x1); unpack8(b1, x1 + 8);
            float d[16]; float ss = 0.f;
#pragma unroll
            for (int e = 0; e < 16; ++e) { d[e] = x0[e] - lam * x1[e]; ss += d[e] * d[e]; }
            ss += __shfl_xor(ss, 1); ss += __shfl_xor(ss, 2); ss += __shfl_xor(ss, 4);
            const float rstd = rsqrtf(ss * (1.0f / 128) + EPS);
#pragma unroll
            for (int e = 0; e < 16; ++e) d[e] = d[e] * rstd * gg[e];
            bf16_t* dst = QG + (size_t)t * QGW + 2048 + h * 128 + e0;
            *(u32x4*)dst = pack8(d); *(u32x4*)(dst + 8) = pack8(d + 8);
        }
    }
    if (p5_needed) SEAM(5);

    if (IN(6)) for (int rep = 0; rep < NREP(6); ++rep) { if (rep) cg::this_grid().sync(); PHASE_IDS();
        {
            const int gw = vcu * NWAVES + wave, NGW = G * NWAVES; LAS float* scr = (LAS float*)(ldsl + wave * 16384);
            for (int it = gw; it < 88 * 64; it += NGW) transpose_item(a.in[I_WFD], DFF, DM, WdT, 0, scr, it, lane);
            __syncthreads(); }
        { pg8::Gemm g{QG, WbrAT, 2048, QGW, 2048}; pg8::StaticOrder S; S.init(MLAT, DM, G, bx);
          pg8::EpiBranch<0> E{Tm, QG, 3072};
          pg8::gemm_phase<pg8::EpiBranch<0>, pg8::StaticOrder>(ldsl, g, S, E); }
        { pg8::Gemm g{QG + 2048, WbrBT, 1024, QGW, 1024}; pg8::StaticOrder S; S.init(MLAT, DM, G, bx);
          pg8::EpiBranch<1> E{Tm, QG, 5120};
          pg8::gemm_phase<pg8::EpiBranch<1>, pg8::StaticOrder>(ldsl, g, S, E); }
    }
    SEAM(6);

    if (IN(7)) for (int rep = 0; rep < NREP(7); ++rep) { if (rep) cg::this_grid().sync(); PHASE_IDS();
        pg8::Gemm g{Tm, WoutT, DM, DM, DM}; pg8::StaticOrder S; S.init(MLAT, DM, G, bx);
        pg8::EpiResid E{a.in[I_X], a.out, MOD + 2 * DM};
        pg8::gemm_phase<pg8::EpiResid, pg8::StaticOrder>(ldsl, g, S, E);
    }
    SEAM(7);

    if (IN(8)) for (int rep = 0; rep < NREP(8); ++rep) { if (rep) cg::this_grid().sync(); PHASE_IDS();
        LAS float* mA = (LAS float*)ldsl; LAS float* mS = mA + DM; const float* g2 = a.in[I_N2G];
        for (int q = bx; q < 256; q += G) {
            const int cond = q >> 6;
            __syncthreads();
            for (int col = tid; col < DM; col += NTHREADS) { mA[col] = g2[col] * (1.0f + MOD[(size_t)cond * ADAW + 4 * DM + col]); mS[col] = MOD[(size_t)cond * ADAW + 3 * DM + col]; }
            __syncthreads();
            norm_chunk(a.out, H2, q * 64, mA, mS, wave, lane);
        }
        __syncthreads();
    }
    SEAM(8);

    if (IN(9)) for (int rep = 0; rep < NREP(9); ++rep) { if (rep) cg::this_grid().sync(); PHASE_IDS();
        pg8::Gemm g{H2, WguT, DM, DM, DM}; pg8::StaticOrder S; S.init(MLAT, 2 * DFF, G, bx);
        pg8::EpiSwiglu E{HM};
        pg8::gemm_phase<pg8::EpiSwiglu, pg8::StaticOrder>(ldsl, g, S, E);
    }
    SEAM(9);

    if (IN(10)) for (int rep = 0; rep < NREP(10); ++rep) { if (rep) cg::this_grid().sync(); PHASE_IDS();
        pg8::Gemm g{HM, WdT, DFF, DFF, DFF}; pg8::StaticOrder S; S.init(MLAT, DM, G, bx);
        pg8::EpiResid E{a.out, a.out, MOD + 5 * DM};
        pg8::gemm_phase<pg8::EpiResid, pg8::StaticOrder>(ldsl, g, S, E);
    }
    if (REPMASK & 2048) { for (int i = 0; i < 10; ++i) cg::this_grid().sync(); }
#undef IN
#undef SEAM
}

extern "C" void kernel_launch(void* const* d_in, const int* in_sizes, int n_in, void* d_out, int out_size, void* d_ws, size_t ws_size, hipStream_t stream) {
    static int grid = 0;
    if (grid == 0) {
        if (n_in != 24 || in_sizes[0] != MLAT * DM || out_size != MLAT * DM || ws_size < WS_END) {
            fprintf(stderr, "kernel_launch: unexpected shapes (n_in %d, in0 %d, out %d, ws %zu)\n", n_in, n_in > 0 ? in_sizes[0] : -1, out_size, ws_size); grid = -1; return; }
        int dev = 0, cus = 0, per_cu = 0;
        if (hipGetDevice(&dev) != hipSuccess || hipDeviceGetAttribute(&cus, hipDeviceAttributeMultiprocessorCount, dev) != hipSuccess) { grid = -1; return; }
        if (hipFuncSetAttribute((const void*)fwd_kernel, hipFuncAttributeMaxDynamicSharedMemorySize, LDS_BYTES) != hipSuccess) { fprintf(stderr, "kernel_launch: hipFuncSetAttribute failed\n"); grid = -1; return; }
        if (hipOccupancyMaxActiveBlocksPerMultiprocessor(&per_cu, (const void*)fwd_kernel, NTHREADS, LDS_BYTES) != hipSuccess || per_cu < 1) { fprintf(stderr, "kernel_launch: occupancy query failed (%d)\n", per_cu); per_cu = 1; }
        (void)hipGetLastError();
        grid = cus * per_cu;
        if (grid > 256) grid = 256;
    }
    if (grid < 0) return;
    Args a{};
    for (int i = 0; i < 24; ++i) a.in[i] = (const float*)d_in[i];
    a.out = (float*)d_out; a.ws = (unsigned char*)d_ws;
#if MK_SINGLE
    (void)hipMemsetAsync((char*)d_ws + WS_BAR, 0, XCD_BAR_WORDS * 4, stream);
    a.ph_lo = 0; a.ph_hi = NPHASES;
    void* args[] = {&a};
    hipError_t e = hipLaunchCooperativeKernel((void*)fwd_kernel, dim3(grid), dim3(NTHREADS), args, LDS_BYTES, stream);
    if (e != hipSuccess) fprintf(stderr, "cooperative launch failed: %s (grid %d)\n", hipGetErrorString(e), grid);
#else
    for (int p = 0; p < NPHASES; ++p) {
        a.ph_lo = p; a.ph_hi = p + 1;
        hipLaunchKernelGGL(fwd_kernel, dim3(grid), dim3(NTHREADS), LDS_BYTES, stream, a);
    }
#endif
}
```
